# Optimizing an MI355X kernel written in HIP

```python
import math
import jax
import jax.numpy as jnp
from jax import lax
import numpy as np

D_MODEL = 1024
BATCH = 4
SEQ = 8192
DEPTH = 2

GRID_W = 64
CTX_LEN = 256
NORM_EPS = 1e-6
N_BRANCHES = 4

S5_WIDTH = 256
S5_GROUP_SIZE = 16
S5_GROUPS = S5_WIDTH // S5_GROUP_SIZE
S5_STATE = 64
S5_DT_MIN = 1e-3
S5_DT_MAX = 1e-1

GLA_HEADS = 4
GLA_DK = 64
GLA_DV = 128
GLA_GATE_RANK = 16
GLA_TAU = 16.0
GLA_CHUNK = 64
ROPE_BASE = 10000.0

NA_HEADS = 4
NA_HEAD_DIM = 64
NA_WIN_ROWS = 8
NA_WIN_COLS = 16

CONV_WIDTH = 256
CONV_KERNEL = 31

MOE_GROUPS = 4
MOE_EXPERTS_PER_GROUP = 8
MOE_TOP_K = 2
MOE_HIDDEN = 256

IN_PARTS = (
    ('s5_u', S5_WIDTH),
    ('gla_q', GLA_HEADS * GLA_DK),
    ('gla_k', GLA_HEADS * GLA_DK),
    ('gla_v', GLA_HEADS * GLA_DV),
    ('gla_r', GLA_HEADS * GLA_DV),
    ('gla_a', 2 * GLA_GATE_RANK),
    ('na_q', NA_HEADS * NA_HEAD_DIM),
    ('na_k', NA_HEADS * NA_HEAD_DIM),
    ('na_v', NA_HEADS * NA_HEAD_DIM),
    ('conv_in', 2 * CONV_WIDTH),
    ('gates', N_BRANCHES * D_MODEL),
)
IN_WIDTH = sum(width for _, width in IN_PARTS)
ALL_PARTS = tuple(name for name, _ in IN_PARTS)
CTX_STATE_PARTS = ('s5_u', 'gla_k', 'gla_v', 'gla_a', 'na_k', 'na_v')

kernel_name = 'hybrid_prefix_ssm_gla_natten_conv_hmoe'


def _orient(a, reverse):
    return jnp.flip(a, axis=1) if reverse else a


def rms_norm(x, g):
    xf = x.astype(jnp.float32)
    y = xf * lax.rsqrt(jnp.mean(xf * xf, axis=-1, keepdims=True) + NORM_EPS)
    return (y * g.astype(jnp.float32)).astype(x.dtype)


def layer_norm(x, g, b):
    xf = x.astype(jnp.float32)
    xc = xf - jnp.mean(xf, axis=-1, keepdims=True)
    y = xc * lax.rsqrt(jnp.mean(xc * xc, axis=-1, keepdims=True) + NORM_EPS)
    return (y * g.astype(jnp.float32) + b.astype(jnp.float32)).astype(x.dtype)


def modulate(x, g, shift, scale):
    return rms_norm(x, g) * (1 + scale) + shift


def in_proj(h, w_in, names):
    offsets = {}
    start = 0
    for name, width in IN_PARTS:
        offsets[name] = (start, width)
        start += width
    if tuple(names) == ALL_PARTS:
        w = w_in
    else:
        w = jnp.concatenate([w_in[:, offsets[n][0]:offsets[n][0] + offsets[n][1]] for n in names], axis=1)
    y = h @ w
    out = {}
    col = 0
    for n in names:
        width = offsets[n][1]
        out[n] = y[..., col:col + width]
        col += width
    return out


def s5_discretise(lam_re, lam_im, log_dt, b_re, b_im):
    lr = lam_re.astype(jnp.float32)
    li = lam_im.astype(jnp.float32)
    dt = jnp.exp(log_dt.astype(jnp.float32))[:, None]
    mag = jnp.exp(lr * dt)
    abar_re = mag * jnp.cos(li * dt)
    abar_im = mag * jnp.sin(li * dt)
    den = lr * lr + li * li
    nr = abar_re - 1.0
    ni = abar_im
    coef_re = (nr * lr + ni * li) / den
    coef_im = (ni * lr - nr * li) / den
    br = b_re.astype(jnp.float32)
    bi = b_im.astype(jnp.float32)
    bbar_re = coef_re[..., None] * br - coef_im[..., None] * bi
    bbar_im = coef_re[..., None] * bi + coef_im[..., None] * br
    return abar_re, abar_im, bbar_re, bbar_im


def _ssm_combine(e1, e2):
    a1r, a1i, b1r, b1i = e1
    a2r, a2i, b2r, b2i = e2
    ar = a1r * a2r - a1i * a2i
    ai = a1r * a2i + a1i * a2r
    br = a2r * b1r - a2i * b1i + b2r
    bi = a2r * b1i + a2i * b1r + b2i
    return ar, ai, br, bi


def s5_states(u, abar_re, abar_im, bbar_re, bbar_im, h0_re, h0_im):
    bu_re = jnp.einsum('blgh,gph->blgp', u, bbar_re)
    bu_im = jnp.einsum('blgh,gph->blgp', u, bbar_im)
    if h0_re is not None:
        bu_re = bu_re.at[:, 0].add(abar_re * h0_re - abar_im * h0_im)
        bu_im = bu_im.at[:, 0].add(abar_re * h0_im + abar_im * h0_re)
    length = u.shape[1]
    a_re = jnp.broadcast_to(abar_re, (1, length) + abar_re.shape)
    a_im = jnp.broadcast_to(abar_im, (1, length) + abar_im.shape)
    _, _, h_re, h_im = lax.associative_scan(_ssm_combine, (a_re, a_im, bu_re, bu_im), axis=1)
    return h_re, h_im


def s5_readout(h_re, h_im, c_re, c_im):
    return jnp.einsum('blgp,ghp->blgh', h_re, c_re) - jnp.einsum('blgp,ghp->blgh', h_im, c_im)


def s5_output(y, lp):
    z = jax.nn.gelu(y)
    z = z * jax.nn.sigmoid(z @ lp['s5_w_glu'].astype(jnp.float32) + lp['s5_b_glu'].astype(jnp.float32))
    return z.astype(lp['s5_w_out'].dtype) @ lp['s5_w_out']


def s5_mixer(u, uc, lp, ctx_out):
    bsz, length, _ = u.shape
    lc = uc.shape[1]
    uf = u.astype(jnp.float32)
    ucf = uc.astype(jnp.float32)
    ug = uf.reshape(bsz, length, S5_GROUPS, S5_GROUP_SIZE)
    ucg = ucf.reshape(bsz, lc, S5_GROUPS, S5_GROUP_SIZE)
    d_skip = lp['s5_d'].astype(jnp.float32)
    y = uf * d_skip
    yc = ucf * d_skip if ctx_out else None
    for direction in range(2):
        rev = direction == 1
        abr, abi, bbr, bbi = s5_discretise(lp['s5_lam_re'][direction], lp['s5_lam_im'][direction],
                                           lp['s5_log_dt'][direction], lp['s5_b_re'][direction],
                                           lp['s5_b_im'][direction])
        c_re = lp['s5_c_re'][direction].astype(jnp.float32)
        c_im = lp['s5_c_im'][direction].astype(jnp.float32)
        hcr, hci = s5_states(_orient(ucg, rev), abr, abi, bbr, bbi, None, None)
        hr, hi = s5_states(_orient(ug, rev), abr, abi, bbr, bbi, hcr[:, -1], hci[:, -1])
        y = y + _orient(s5_readout(hr, hi, c_re, c_im), rev).reshape(bsz, length, S5_WIDTH)
        if ctx_out:
            yc = yc + _orient(s5_readout(hcr, hci, c_re, c_im), rev).reshape(bsz, lc, S5_WIDTH)
    out = s5_output(y, lp)
    outc = s5_output(yc, lp) if ctx_out else None
    return out, outc


def axial_rope_angles(length, dim):
    t = jnp.arange(length, dtype=jnp.int32)
    row = (t // GRID_W).astype(jnp.float32)
    col = (t % GRID_W).astype(jnp.float32)
    half = dim // 2
    inv_freq = ROPE_BASE ** (-jnp.arange(0, half, 2, dtype=jnp.float32) / half)
    return row[:, None] * inv_freq, col[:, None] * inv_freq


def _rotate(x, ang):
    f = x.shape[-1] // 2
    cos = jnp.cos(ang)[:, None, :]
    sin = jnp.sin(ang)[:, None, :]
    x1 = x[..., :f]
    x2 = x[..., f:]
    return jnp.concatenate([x1 * cos - x2 * sin, x2 * cos + x1 * sin], axis=-1)


def apply_axial_rope(x, ang_row, ang_col):
    half = x.shape[-1] // 2
    return jnp.concatenate([_rotate(x[..., :half], ang_row), _rotate(x[..., half:], ang_col)], axis=-1)


def gla_log_gates(a_low, w_a2, b_a):
    gates = []
    for direction in range(2):
        z = a_low[..., direction * GLA_GATE_RANK:(direction + 1) * GLA_GATE_RANK] @ w_a2[direction] + b_a[direction]
        g = jax.nn.log_sigmoid(z.astype(jnp.float32)) / GLA_TAU
        gates.append(g.reshape(g.shape[0], g.shape[1], GLA_HEADS, GLA_DK))
    return gates


def gla_chunk_states(k, v, g, s0):
    bsz, length, nh, dk = k.shape
    n = length // GLA_CHUNK
    kc = k.reshape(bsz, n, GLA_CHUNK, nh, dk)
    vc = v.reshape(bsz, n, GLA_CHUNK, nh, v.shape[-1])
    b = jnp.cumsum(g.reshape(bsz, n, GLA_CHUNK, nh, dk), axis=2)
    b_last = b[:, :, -1]
    k_end = kc * jnp.exp(b_last[:, :, None] - b)
    kv = jnp.einsum('bnchd,bnche->bnhde', k_end, vc)
    decay = jnp.exp(b_last)

    def step(s, inp):
        dec, kv_n = inp
        return dec[..., None] * s + kv_n, s

    s_final, s_before = lax.scan(step, s0, (jnp.moveaxis(decay, 1, 0), jnp.moveaxis(kv, 1, 0)))
    return jnp.moveaxis(s_before, 0, 1), s_final, b


def gla_chunk_output(q, k, v, b, s_before):
    bsz, length, nh, dk = q.shape
    n = length // GLA_CHUNK
    dv = v.shape[-1]
    qc = q.reshape(bsz, n, GLA_CHUNK, nh, dk)
    kc = k.reshape(bsz, n, GLA_CHUNK, nh, dk)
    vc = v.reshape(bsz, n, GLA_CHUNK, nh, dv)
    q_t = qc * jnp.exp(b)
    k_t = kc * jnp.exp(-b)
    att = jnp.einsum('bnihd,bnjhd->bnhij', q_t, k_t)
    mask = jnp.tril(jnp.ones((GLA_CHUNK, GLA_CHUNK), dtype=bool))
    att = jnp.where(mask, att, 0.0)
    o = jnp.einsum('bnhij,bnjhe->bnihe', att, vc) + jnp.einsum('bnihd,bnhde->bnihe', q_t, s_before)
    return o.reshape(bsz, length, nh, dv)


def gla_readout(o, r, norm_g, w_out):
    of = o * lax.rsqrt(jnp.mean(o * o, axis=-1, keepdims=True) + NORM_EPS) * norm_g.astype(jnp.float32)
    rf = jax.nn.silu(r.astype(jnp.float32)).reshape(o.shape)
    y = (of * rf).reshape(o.shape[0], o.shape[1], GLA_HEADS * GLA_DV)
    return y.astype(w_out.dtype) @ w_out


def gla_mixer(p, pc, lp, ctx_out):
    bsz, length, _ = p['gla_k'].shape

    def heads(a, dh):
        return a.astype(jnp.float32).reshape(a.shape[0], a.shape[1], GLA_HEADS, dh)

    scale = GLA_DK ** -0.5
    ang_r, ang_c = axial_rope_angles(length, GLA_DK)
    q = apply_axial_rope(heads(p['gla_q'], GLA_DK), ang_r, ang_c) * scale
    k = apply_axial_rope(heads(p['gla_k'], GLA_DK), ang_r, ang_c)
    v = heads(p['gla_v'], GLA_DV)
    kc = heads(pc['gla_k'], GLA_DK)
    vc = heads(pc['gla_v'], GLA_DV)
    qc = heads(pc['gla_q'], GLA_DK) * scale if ctx_out else None
    g = gla_log_gates(p['gla_a'], lp['gla_w_a2'], lp['gla_b_a'])
    gc = gla_log_gates(pc['gla_a'], lp['gla_w_a2'], lp['gla_b_a'])
    s0 = jnp.zeros((bsz, GLA_HEADS, GLA_DK, GLA_DV), jnp.float32)
    o = jnp.zeros_like(v)
    oc = jnp.zeros_like(vc) if ctx_out else None
    for direction in range(2):
        rev = direction == 1
        kcd, vcd, gcd = _orient(kc, rev), _orient(vc, rev), _orient(gc[direction], rev)
        sb_c, sf_c, b_c = gla_chunk_states(kcd, vcd, gcd, s0)
        if ctx_out:
            oc = oc + _orient(gla_chunk_output(_orient(qc, rev), kcd, vcd, b_c, sb_c), rev)
        kd, vd, gd = _orient(k, rev), _orient(v, rev), _orient(g[direction], rev)
        sb, _, b = gla_chunk_states(kd, vd, gd, sf_c)
        o = o + _orient(gla_chunk_output(_orient(q, rev), kd, vd, b, sb), rev)
    out = gla_readout(o, p['gla_r'], lp['gla_norm_g'], lp['gla_w_out'])
    outc = gla_readout(oc, pc['gla_r'], lp['gla_norm_g'], lp['gla_w_out']) if ctx_out else None
    return out, outc


def na_mixer(p, pc, lp, ctx_out):
    bsz, length, _ = p['na_q'].shape
    lc = pc['na_k'].shape[1]
    rows = length // GRID_W
    wr = min(NA_WIN_ROWS, rows)
    scale = NA_HEAD_DIM ** -0.5
    grid = (bsz, rows, GRID_W, NA_HEADS, NA_HEAD_DIM)
    q = p['na_q'].astype(jnp.float32).reshape(grid) * scale
    k = p['na_k'].astype(jnp.float32).reshape(grid)
    v = p['na_v'].astype(jnp.float32).reshape(grid)
    kc = pc['na_k'].astype(jnp.float32).reshape(bsz, lc, NA_HEADS, NA_HEAD_DIM)
    vc = pc['na_v'].astype(jnp.float32).reshape(bsz, lc, NA_HEADS, NA_HEAD_DIM)
    r_idx = jnp.arange(rows)
    c_idx = jnp.arange(GRID_W)
    row_start = jnp.clip(r_idx - wr // 2, 0, rows - wr)
    col_start = jnp.clip(c_idx - NA_WIN_COLS // 2, 0, GRID_W - NA_WIN_COLS)
    col_in = (c_idx[None, :] >= col_start[:, None]) & (c_idx[None, :] < col_start[:, None] + NA_WIN_COLS)
    dc_idx = jnp.clip(c_idx[None, :] - c_idx[:, None] + NA_WIN_COLS - 1, 0, 2 * NA_WIN_COLS - 2)
    rpb = lp['na_rpb'].astype(jnp.float32)
    scores = []
    key_rows = []
    for off in range(wr):
        kr = row_start + off
        dr_idx = kr - r_idx + NA_WIN_ROWS - 1
        bias = rpb[:, dr_idx][:, :, dc_idx]
        s = jnp.einsum('brqhd,brkhd->bhrqk', q, k[:, kr]) + bias[None]
        scores.append(jnp.where(col_in, s, -jnp.inf))
        key_rows.append(kr)
    s_lat = jnp.stack(scores, axis=4)
    s_ctx = jnp.einsum('brqhd,bchd->bhrqc', q, kc)
    m = jnp.maximum(jnp.max(s_lat, axis=(4, 5)), jnp.max(s_ctx, axis=-1))
    p_lat = jnp.exp(s_lat - m[..., None, None])
    p_ctx = jnp.exp(s_ctx - m[..., None])
    denom = jnp.sum(p_lat, axis=(4, 5)) + jnp.sum(p_ctx, axis=-1)
    o = jnp.einsum('bhrqc,bchd->brqhd', p_ctx, vc)
    for off, kr in enumerate(key_rows):
        o = o + jnp.einsum('bhrqk,brkhd->brqhd', p_lat[:, :, :, :, off], v[:, kr])
    o = o / jnp.transpose(denom, (0, 2, 3, 1))[..., None]
    w_out = lp['na_w_out']
    out = o.reshape(bsz, length, NA_HEADS * NA_HEAD_DIM).astype(w_out.dtype) @ w_out
    if not ctx_out:
        return out, None
    qc = pc['na_q'].astype(jnp.float32).reshape(bsz, lc, NA_HEADS, NA_HEAD_DIM) * scale
    pcw = jax.nn.softmax(jnp.einsum('bqhd,bkhd->bhqk', qc, kc), axis=-1)
    oc = jnp.einsum('bhqk,bkhd->bqhd', pcw, vc).reshape(bsz, lc, NA_HEADS * NA_HEAD_DIM)
    return out, oc.astype(w_out.dtype) @ w_out


def conformer_conv(a, dw, dw_b, ln_g, ln_b, w_out):
    val, gate = jnp.split(a, 2, axis=-1)
    y = (val * jax.nn.sigmoid(gate)).astype(dw.dtype)
    y = lax.conv_general_dilated(y, dw[:, None, :], window_strides=(1,),
                                 padding=((CONV_KERNEL // 2, CONV_KERNEL // 2),),
                                 dimension_numbers=('NWC', 'WIO', 'NWC'),
                                 feature_group_count=CONV_WIDTH) + dw_b
    y = jax.nn.silu(layer_norm(y, ln_g, ln_b))
    return y @ w_out


def merge_branches(gate_pre, gate_b, branches, w_out):
    g = jax.nn.sigmoid(gate_pre + gate_b).reshape(gate_pre.shape[:-1] + (N_BRANCHES, D_MODEL))
    merged = g[..., 0, :] * branches[0]
    for i in range(1, N_BRANCHES):
        merged = merged + g[..., i, :] * branches[i]
    return merged @ w_out


def token_mixer(h, hc, lp, ctx_out):
    p = in_proj(h, lp['w_in'], ALL_PARTS)
    pc = in_proj(hc, lp['w_in'], ALL_PARTS if ctx_out else CTX_STATE_PARTS)
    y_s5, yc_s5 = s5_mixer(p['s5_u'], pc['s5_u'], lp, ctx_out)
    y_gla, yc_gla = gla_mixer(p, pc, lp, ctx_out)
    y_na, yc_na = na_mixer(p, pc, lp, ctx_out)
    conv_args = (lp['conv_dw'], lp['conv_dw_b'], lp['conv_ln_g'], lp['conv_ln_b'], lp['conv_w_out'])
    y_cv = conformer_conv(p['conv_in'], *conv_args)
    out = merge_branches(p['gates'], lp['gate_b'], (y_s5, y_gla, y_na, y_cv), lp['w_mix_out'])
    if not ctx_out:
        return out, None
    yc_cv = conformer_conv(pc['conv_in'], *conv_args)
    outc = merge_branches(pc['gates'], lp['gate_b'], (yc_s5, yc_gla, yc_na, yc_cv), lp['w_mix_out'])
    return out, outc


def hierarchical_moe(h, w_group, b_group, w_expert, b_expert, w1, w3, w2):
    shape = h.shape
    t = h.reshape(-1, shape[-1])
    n_tok = t.shape[0]
    group_prob = jax.nn.softmax((t @ w_group + b_group).astype(jnp.float32), axis=-1)
    group_p, group_idx = lax.top_k(group_prob, 1)
    exp_logits = (t @ w_expert + b_expert).astype(jnp.float32).reshape(n_tok, MOE_GROUPS, MOE_EXPERTS_PER_GROUP)
    sel_logits = jnp.take_along_axis(exp_logits, group_idx[:, :, None], axis=1)[:, 0]
    top_val, top_idx = lax.top_k(sel_logits, MOE_TOP_K)
    top_w = jax.nn.softmax(top_val, axis=-1) * group_p
    slot_w = jnp.sum(top_w[..., None] * jax.nn.one_hot(top_idx, MOE_EXPERTS_PER_GROUP, dtype=jnp.float32), axis=1)
    combine = (jax.nn.one_hot(group_idx[:, 0], MOE_GROUPS, dtype=jnp.float32)[:, :, None]
               * slot_w[:, None, :]).astype(t.dtype)
    y = jnp.zeros_like(t)
    for gi in range(MOE_GROUPS):
        a = jnp.einsum('td,edf->tef', t, w1[gi])
        b = jnp.einsum('td,edf->tef', t, w3[gi])
        act = jax.nn.silu(a) * b * combine[:, gi, :, None]
        y = y + jnp.einsum('tef,efd->td', act, w2[gi])
    return y.reshape(shape)


def setup_inputs(seed: int = 0) -> dict:
    key = jax.random.key(seed)
    keys = iter(jax.random.split(key, 64))

    def nrm(shape, scale):
        return jax.random.normal(next(keys), shape, jnp.float32) * scale

    def gain(shape):
        return 1.0 + nrm(shape, 0.05)

    G, P, H = S5_GROUPS, S5_STATE, S5_GROUP_SIZE
    n_exp = MOE_GROUPS * MOE_EXPERTS_PER_GROUP
    lam_im_base = jnp.pi * jnp.arange(P, dtype=jnp.float32)
    return {
        'x': nrm((BATCH, SEQ, D_MODEL), 1.0),
        'c': nrm((BATCH, D_MODEL), 1.0),
        'ctx': nrm((BATCH, CTX_LEN, D_MODEL), 1.0),
        'c_ctx': nrm((D_MODEL,), 1.0),
        'norm1_g': gain((DEPTH, D_MODEL)),
        'norm2_g': gain((DEPTH, D_MODEL)),
        'w_mod': nrm((DEPTH, D_MODEL, 6 * D_MODEL), 0.5 * D_MODEL ** -0.5),
        'b_mod': nrm((DEPTH, 6 * D_MODEL), 0.02),
        'w_in': nrm((DEPTH, D_MODEL, IN_WIDTH), D_MODEL ** -0.5),
        'gate_b': nrm((DEPTH, N_BRANCHES * D_MODEL), 0.1),
        'w_mix_out': nrm((DEPTH, D_MODEL, D_MODEL), D_MODEL ** -0.5),
        's5_lam_re': -0.5 + nrm((DEPTH, 2, G, P), 0.01),
        's5_lam_im': lam_im_base + nrm((DEPTH, 2, G, P), 0.01),
        's5_log_dt': jax.random.uniform(next(keys), (DEPTH, 2, G), jnp.float32,
                                        minval=math.log(S5_DT_MIN), maxval=math.log(S5_DT_MAX)),
        's5_b_re': nrm((DEPTH, 2, G, P, H), (2 * H) ** -0.5),
        's5_b_im': nrm((DEPTH, 2, G, P, H), (2 * H) ** -0.5),
        's5_c_re': nrm((DEPTH, 2, G, H, P), 0.5),
        's5_c_im': nrm((DEPTH, 2, G, H, P), 0.5),
        's5_d': nrm((DEPTH, S5_WIDTH), 0.5),
        's5_w_glu': nrm((DEPTH, S5_WIDTH, S5_WIDTH), S5_WIDTH ** -0.5),
        's5_b_glu': nrm((DEPTH, S5_WIDTH), 0.02),
        's5_w_out': nrm((DEPTH, S5_WIDTH, D_MODEL), S5_WIDTH ** -0.5),
        'gla_w_a2': nrm((DEPTH, 2, GLA_GATE_RANK, GLA_HEADS * GLA_DK), GLA_GATE_RANK ** -0.5),
        'gla_b_a': nrm((DEPTH, 2, GLA_HEADS * GLA_DK), 0.1),
        'gla_norm_g': gain((DEPTH, GLA_DV)),
        'gla_w_out': nrm((DEPTH, GLA_HEADS * GLA_DV, D_MODEL), (GLA_HEADS * GLA_DV) ** -0.5),
        'na_rpb': nrm((DEPTH, NA_HEADS, 2 * NA_WIN_ROWS - 1, 2 * NA_WIN_COLS - 1), 0.1),
        'na_w_out': nrm((DEPTH, NA_HEADS * NA_HEAD_DIM, D_MODEL), (NA_HEADS * NA_HEAD_DIM) ** -0.5),
        'conv_dw': nrm((DEPTH, CONV_KERNEL, CONV_WIDTH), CONV_KERNEL ** -0.5),
        'conv_dw_b': nrm((DEPTH, CONV_WIDTH), 0.02),
        'conv_ln_g': gain((DEPTH, CONV_WIDTH)),
        'conv_ln_b': nrm((DEPTH, CONV_WIDTH), 0.02),
        'conv_w_out': nrm((DEPTH, CONV_WIDTH, D_MODEL), CONV_WIDTH ** -0.5),
        'moe_w_group': nrm((DEPTH, D_MODEL, MOE_GROUPS), D_MODEL ** -0.5),
        'moe_b_group': nrm((DEPTH, MOE_GROUPS), 0.01),
        'moe_w_expert': nrm((DEPTH, D_MODEL, n_exp), D_MODEL ** -0.5),
        'moe_b_expert': nrm((DEPTH, n_exp), 0.01),
        'moe_w1': nrm((DEPTH, MOE_GROUPS, MOE_EXPERTS_PER_GROUP, D_MODEL, MOE_HIDDEN), D_MODEL ** -0.5),
        'moe_w3': nrm((DEPTH, MOE_GROUPS, MOE_EXPERTS_PER_GROUP, D_MODEL, MOE_HIDDEN), D_MODEL ** -0.5),
        'moe_w2': nrm((DEPTH, MOE_GROUPS, MOE_EXPERTS_PER_GROUP, MOE_HIDDEN, D_MODEL), MOE_HIDDEN ** -0.5),
        'final_norm_g': gain((D_MODEL,)),
    }


def reference(x, c, ctx, c_ctx, norm1_g, norm2_g, w_mod, b_mod, w_in, gate_b, w_mix_out,
              s5_lam_re, s5_lam_im, s5_log_dt, s5_b_re, s5_b_im, s5_c_re, s5_c_im, s5_d,
              s5_w_glu, s5_b_glu, s5_w_out, gla_w_a2, gla_b_a, gla_norm_g, gla_w_out,
              na_rpb, na_w_out, conv_dw, conv_dw_b, conv_ln_g, conv_ln_b, conv_w_out,
              moe_w_group, moe_b_group, moe_w_expert, moe_b_expert, moe_w1, moe_w3, moe_w2,
              final_norm_g):
    xc = ctx
    c_act = jax.nn.silu(c)
    cc_act = jax.nn.silu(c_ctx)
    for i in range(DEPTH):
        last = i == DEPTH - 1
        lp = {
            'w_in': w_in[i], 'gate_b': gate_b[i], 'w_mix_out': w_mix_out[i],
            's5_lam_re': s5_lam_re[i], 's5_lam_im': s5_lam_im[i], 's5_log_dt': s5_log_dt[i],
            's5_b_re': s5_b_re[i], 's5_b_im': s5_b_im[i], 's5_c_re': s5_c_re[i], 's5_c_im': s5_c_im[i],
            's5_d': s5_d[i], 's5_w_glu': s5_w_glu[i], 's5_b_glu': s5_b_glu[i], 's5_w_out': s5_w_out[i],
            'gla_w_a2': gla_w_a2[i], 'gla_b_a': gla_b_a[i], 'gla_norm_g': gla_norm_g[i],
            'gla_w_out': gla_w_out[i], 'na_rpb': na_rpb[i], 'na_w_out': na_w_out[i],
            'conv_dw': conv_dw[i], 'conv_dw_b': conv_dw_b[i], 'conv_ln_g': conv_ln_g[i],
            'conv_ln_b': conv_ln_b[i], 'conv_w_out': conv_w_out[i],
        }
        moe_args = (moe_w_group[i], moe_b_group[i], moe_w_expert[i], moe_b_expert[i],
                    moe_w1[i], moe_w3[i], moe_w2[i])
        mod = (c_act @ w_mod[i] + b_mod[i])[:, None, :]
        sh1, sc1, g1, sh2, sc2, g2 = jnp.split(mod, 6, axis=-1)
        n_ctx_mod = 2 if last else 6
        modc = cc_act @ w_mod[i][:, :n_ctx_mod * D_MODEL] + b_mod[i][:n_ctx_mod * D_MODEL]
        modc_parts = jnp.split(modc, n_ctx_mod, axis=-1)
        h = modulate(x, norm1_g[i], sh1, sc1)
        hc = modulate(xc, norm1_g[i], modc_parts[0], modc_parts[1])
        mix, mixc = token_mixer(h, hc, lp, not last)
        x = x + g1 * mix
        x = x + g2 * hierarchical_moe(modulate(x, norm2_g[i], sh2, sc2), *moe_args)
        if not last:
            xc = xc + modc_parts[2] * mixc
            xc = xc + modc_parts[5] * hierarchical_moe(modulate(xc, norm2_g[i], modc_parts[3], modc_parts[4]), *moe_args)
    return rms_norm(x, final_norm_g)
```

```cpp
#include <hip/hip_runtime.h>
#include <cstdio>
#include <cstdint>

#define XB_TMO      128
#define XB_XCNT(j)  (256  + 64 * (j))
#define XB_XSUB(j)  (1280 + 64 * (j))
#define XB_XGEN(j)  (2304 + 64 * (j))
#define XB_TOP      3328
#define XB_TOPGEN   3392
#define XCD_BAR_WORDS 3456
#define XB_SPIN_CAP (1u << 18)
#define LAS __attribute__((address_space(3)))

__device__ __forceinline__ unsigned xb_ld(unsigned* p)              { return __hip_atomic_load(p, __ATOMIC_RELAXED, __HIP_MEMORY_SCOPE_AGENT); }
__device__ __forceinline__ unsigned xb_add(unsigned* p, unsigned v) { return __hip_atomic_fetch_add(p, v, __ATOMIC_RELAXED, __HIP_MEMORY_SCOPE_AGENT); }
__device__ __forceinline__ unsigned xb_xcc_id() { return (unsigned)__builtin_amdgcn_s_getreg((3 << 11) | 20) & 0xFu; }
#define XB_SPIN(cond, bar) do { unsigned _sp = 0; while (cond) { __builtin_amdgcn_s_sleep(1); \
    if ((++_sp & 255u) == 0u) { if (xb_ld(&(bar)[XB_TMO])) break; if (_sp > XB_SPIN_CAP) { atomicAdd(&(bar)[XB_TMO], 1u); break; } } } } while (0)

struct Params;
struct XcdBarrier { const __attribute__((address_space(4))) Params* kp; volatile LAS unsigned* st; };

__device__ __forceinline__ unsigned* xb_words(const __attribute__((address_space(4))) Params* kp);
__device__ __forceinline__ XcdBarrier xcd_barrier_post(const __attribute__((address_space(4))) Params* kp, volatile LAS unsigned* st) {
    XcdBarrier b; b.kp = kp; b.st = st;
    if (threadIdx.x == 0) (void)xb_add(&xb_words(kp)[XB_XCNT(xb_xcc_id())], 1u);
    return b;
}
__device__ __forceinline__ void xcd_barrier_complete(unsigned* bar, unsigned x, unsigned& nloc, unsigned& nx) {
    const unsigned G = gridDim.x * gridDim.y * gridDim.z;
    unsigned sum, cnt, mine, sp = 0u;
    for (;;) {
        sum = 0u; cnt = 0u; mine = 0u;
#pragma unroll
        for (unsigned j = 0; j < 16; ++j) { const unsigned c = xb_ld(&bar[XB_XCNT(j)]); sum += c; cnt += (c > 0u) ? 1u : 0u; mine = (j == x) ? c : mine; }
        if (sum == G) break;
        __builtin_amdgcn_s_sleep(1);
        if ((++sp & 255u) == 0u) { if (xb_ld(&bar[XB_TMO])) break; if (sp > XB_SPIN_CAP) { atomicAdd(&bar[XB_TMO], 1u); break; } }
    }
    nloc = mine > 0u ? mine : 1u; nx = cnt > 0u ? cnt : 1u;
}
__device__ __forceinline__ void xcd_barrier(const XcdBarrier& b) {
    asm volatile("s_waitcnt vmcnt(0)" ::: "memory");
    __syncthreads();
    if (threadIdx.x == 0) {
        unsigned* bar = xb_words(b.kp); const unsigned bx = xb_xcc_id();
        __builtin_amdgcn_s_waitcnt(0);
        unsigned nloc = b.st[0], nx = b.st[1];
        if (nloc == 0u) { xcd_barrier_complete(bar, bx, nloc, nx); b.st[0] = nloc; b.st[1] = nx; }
        const unsigned old = xb_add(&bar[XB_XSUB(bx)], 1u);
        const unsigned gen = old / nloc;
        if (old + 1u == (gen + 1u) * nloc) {
            __builtin_amdgcn_fence(__ATOMIC_RELEASE, "agent");
            asm volatile("s_waitcnt vmcnt(0)" ::: "memory");
            const unsigned og = xb_add(&bar[XB_TOP], 1u);
            const unsigned tg = og / nx;
            if (og + 1u == (tg + 1u) * nx) xb_add(&bar[XB_TOPGEN], 1u);
            else XB_SPIN(xb_ld(&bar[XB_TOPGEN]) == tg, bar);
            __builtin_amdgcn_fence(__ATOMIC_ACQUIRE, "agent");
            xb_add(&bar[XB_XGEN(bx)], 1u);
            asm volatile("s_waitcnt vmcnt(0)" ::: "memory");
        } else {
            XB_SPIN(xb_ld(&bar[XB_XGEN(bx)]) == gen, bar);
            __builtin_amdgcn_fence(__ATOMIC_ACQUIRE, "agent");
            asm volatile("s_waitcnt vmcnt(0)" ::: "memory");
        }
    }
    __syncthreads();
}

typedef unsigned short bf16_t;
typedef short bf16x8 __attribute__((ext_vector_type(8)));
typedef float f32x4 __attribute__((ext_vector_type(4)));
typedef long l64x2 __attribute__((ext_vector_type(2)));
typedef int i32x4 __attribute__((ext_vector_type(4)));
typedef int i32x8 __attribute__((ext_vector_type(8)));

constexpr int D = 1024, NB = 4, SEQ = 8192, CTX = 256, RB = CTX + SEQ, R = NB * RB;
constexpr int NT = 512;
constexpr int LDS_BYTES = 163840;
constexpr int NPROJ = 3104;
constexpr size_t O_U = 0, O_GQ = (size_t)4 * 8448 * 256, O_GK = (size_t)4 * 8448 * 512, O_GV = (size_t)4 * 8448 * 768, O_GR = (size_t)4 * 8448 * 1280, O_GA = (size_t)4 * 8448 * 1792,
                 O_NQ = (size_t)4 * 8448 * 1824, O_NK = (size_t)4 * 8448 * 2080, O_NV = (size_t)4 * 8448 * 2336, O_CV = (size_t)4 * 8448 * 2592;
constexpr int C_S5U = 0, C_GQ = 256, C_GK = 512, C_GV = 768, C_GR = 1280, C_GA = 1792, C_NQ = 1824, C_NK = 2080, C_NV = 2336, C_CV = 2592;
constexpr int NCH16 = R / 16;
constexpr int NCH64 = R / 64;
constexpr int MOE_CAP = R;
constexpr int NCLS = 112;
constexpr int MAXTILES = 376;

constexpr size_t WS_CTL = 0;
constexpr size_t CTL_BYTES = 16384 + 65536;
constexpr size_t CTL_CNT = 16384;
constexpr size_t WS_MOD = 16384 + 65536;
constexpr size_t WS_ROPE = WS_MOD + 245760;
constexpr size_t WS_WR = WS_ROPE + 24576;
constexpr size_t WS_A16 = WS_WR + 294912;
constexpr size_t WS_S5W1 = WS_A16 + 32768;
constexpr size_t WS_S5W2 = WS_S5W1 + 8388608;
constexpr size_t WS_WT = WS_S5W2 + 4194304;
constexpr size_t WT_WIN = 0, WT_WG = 3276800, WT_WMIX = 7471104, WT_WGLU = 8519680, WT_WS5O = 8585216, WT_WGLAO = 8847360, WT_WNAO = 9371648, WT_WCVO = 9633792,
                 WT_W13 = 9895936, WT_W2 = 26673152, WT_ELEMS = 35061760;
constexpr size_t WS_HKV = WS_WT + WT_ELEMS * 2;
constexpr size_t WS_PROJ = WS_HKV + 69206016;
constexpr size_t PJ_MERGED = 0, PJ_ACT = 69206016, PJ_PERM = PJ_ACT + 49283072, PJ_TOKW = PJ_PERM + 15138816;
constexpr size_t WS_DECAY = WS_PROJ + 209780736;
constexpr size_t WS_YSUM = WS_DECAY + 1081344;
constexpr size_t WS_GU = WS_YSUM + 17301504;
constexpr size_t WS_HIN = WS_GU + 34603008;
constexpr size_t WS_ZS5 = WS_HIN + 17301504;
constexpr size_t WS_ZNA = WS_ZS5 + 17301504;
constexpr size_t WS_ZCV = WS_ZNA + 17301504;
constexpr size_t WS_XC = WS_ZCV + 17301504;
constexpr size_t WS_BC = WS_XC + 4194304;
constexpr size_t WS_GWB = WS_BC + 34603008;
constexpr size_t WS_WG8 = WS_GWB + 81920;
constexpr size_t WS_END = WS_WG8 + 4194304;
constexpr size_t OUT_H8 = 75497472;

struct Params {
    const float* in[41];
    float* out;
    unsigned char* ws;
};

typedef const __attribute__((address_space(4))) Params* KP;
__device__ __forceinline__ unsigned* xb_words(KP kp) { return (unsigned*)kp->ws; }
extern __shared__ __attribute__((aligned(16))) unsigned char smem[];

__device__ __forceinline__ int tidx() { int t = threadIdx.x; asm volatile("" : "+v"(t)); return t; }
__device__ __forceinline__ float bf2f(unsigned v) { return __uint_as_float(v << 16); }
typedef __bf16 bf16x2_t __attribute__((ext_vector_type(2)));
__device__ __forceinline__ unsigned pk2(float a, float b) { const bf16x2_t v = {(__bf16)a, (__bf16)b}; return __builtin_bit_cast(unsigned, v); }
__device__ __forceinline__ unsigned f2bf(float f) { return (unsigned)__builtin_bit_cast(unsigned short, (__bf16)f); }
__device__ __forceinline__ float sigm(float x) { return __builtin_amdgcn_rcpf(1.f + __expf(-x)); }
__device__ __forceinline__ float gelu_t(float x) { return x * sigm(1.5957691216057308f * (x + 0.044715f * x * x * x)); }
template <int CTRL> __device__ __forceinline__ float dpp_f(float v) { return __int_as_float(__builtin_amdgcn_update_dpp(0, __float_as_int(v), CTRL, 0xF, 0xF, true)); }
__device__ __forceinline__ float row16_sum(float v) { v += dpp_f<0xB1>(v); v += dpp_f<0x4E>(v); v += dpp_f<0x141>(v); v += dpp_f<0x140>(v); return v; }
__device__ __forceinline__ float row16_max(float v) { v = fmaxf(v, dpp_f<0xB1>(v)); v = fmaxf(v, dpp_f<0x4E>(v)); v = fmaxf(v, dpp_f<0x141>(v)); v = fmaxf(v, dpp_f<0x140>(v)); return v; }
__device__ __forceinline__ float wave_prefix_sum(float v) {
    v += dpp_f<0x111>(v); v += dpp_f<0x112>(v); v += dpp_f<0x114>(v); v += dpp_f<0x118>(v);
    const float t0 = __int_as_float(__builtin_amdgcn_readlane(__float_as_int(v), 15)), t1 = __int_as_float(__builtin_amdgcn_readlane(__float_as_int(v), 31)), t2 = __int_as_float(__builtin_amdgcn_readlane(__float_as_int(v), 47));
    const int row = (int)(threadIdx.x & 63) >> 4;
    return v + (row >= 1 ? t0 : 0.f) + (row >= 2 ? t1 : 0.f) + (row >= 3 ? t2 : 0.f);
}
__device__ __forceinline__ float wave_suffix_sum(float v) {
    v += dpp_f<0x101>(v); v += dpp_f<0x102>(v); v += dpp_f<0x104>(v); v += dpp_f<0x108>(v);
    const float t1 = __int_as_float(__builtin_amdgcn_readlane(__float_as_int(v), 16)), t2 = __int_as_float(__builtin_amdgcn_readlane(__float_as_int(v), 32)), t3 = __int_as_float(__builtin_amdgcn_readlane(__float_as_int(v), 48));
    const int row = (int)(threadIdx.x & 63) >> 4;
    return v + (row <= 2 ? t3 : 0.f) + (row <= 1 ? t2 : 0.f) + (row <= 0 ? t1 : 0.f);
}
__device__ __forceinline__ float wave_sum(float v) { v = row16_sum(v); v += __shfl_xor(v, 16); v += __shfl_xor(v, 32); return v; }
__device__ __forceinline__ const float* xsrc_row(KP p, int layer, int r) {
    const int b = r / RB, i = r % RB;
    if (i < CTX) return (layer == 0 ? p->in[2] : (const float*)(p->ws + WS_XC)) + ((size_t)b * CTX + i) * D;
    return (layer == 0 ? p->in[0] : (const float*)p->out) + ((size_t)b * SEQ + (i - CTX)) * D;
}
__device__ __forceinline__ float* xdst_row(KP p, int r) {
    const int b = r / RB, i = r % RB;
    if (i < CTX) return (float*)(p->ws + WS_XC) + ((size_t)b * CTX + i) * D;
    return p->out + ((size_t)b * SEQ + (i - CTX)) * D;
}
__device__ __forceinline__ bf16_t* xb_row(KP p, int r) { const int b = r / RB, i = r % RB; return (bf16_t*)p->out + ((size_t)b * SEQ + (i - CTX)) * D; }
__device__ __forceinline__ bf16_t* x2_row(KP p, int layer, int r) { const int b = r / RB, i = r % RB; return (layer == 0 ? (bf16_t*)p->out : (bf16_t*)(p->ws + WS_HKV)) + ((size_t)b * SEQ + (i - CTX)) * D; }
__device__ __forceinline__ unsigned f8x4(float a, float b, float c, float d) { return (unsigned)__builtin_amdgcn_cvt_pk_fp8_f32(c, d, __builtin_amdgcn_cvt_pk_fp8_f32(a, b, 0, false), true); }
__device__ __forceinline__ float4 bf4(uint2 v) { return make_float4(__uint_as_float(v.x << 16), __uint_as_float(v.x & 0xFFFF0000u), __uint_as_float(v.y << 16), __uint_as_float(v.y & 0xFFFF0000u)); }
__device__ __forceinline__ unsigned char* kv_base(KP p, int layer) { return layer == 0 ? (unsigned char*)p->out : p->ws + WS_HKV; }
__device__ __forceinline__ const float* mod_vec(KP p, int layer, int r) {
    const int b = r / RB, i = r % RB;
    return (const float*)(p->ws + WS_MOD) + ((size_t)layer * 5 + (i < CTX ? 4 : b)) * 6144;
}

template <int BM, int BN, int WM, int WN>
struct GT {
    static constexpr int WTM = BM / WM, WTN = BN / WN, MT = WTM / 16, NTL = WTN / 16;
    static constexpr int AI = BM * 8 / NT, BI = BN * 8 / NT;
    static constexpr int ABYTES = BM * 128, BBYTES = BN * 128, STAGE = ABYTES + BBYTES;
};
__device__ __forceinline__ int st_row(int i) { return (i * NT + tidx()) >> 3; }
__device__ __forceinline__ int st_chunk(int i) { const int q = i * NT + tidx(); return (q & 7) ^ ((q >> 3) & 7); }

template <int BM, int BN, int WM, int WN, class SegF, class EpiF>
__device__ __forceinline__ void gemm_stream(SegF&& segf, EpiF&& epi, unsigned char* lds) {
    typedef GT<BM, BN, WM, WN> G;
    constexpr int NL = G::AI + G::BI;
    const int tid = tidx(), lane = tid & 63, wave = tid >> 6, wm = wave / WN, wn = wave % WN, fr = lane & 15, fq = lane >> 4;
    const int aoff = (wm * G::WTM + fr) * 128, boff = G::ABYTES + (wn * G::WTN + fr) * 128;
    const int sw0 = ((0 + fq) ^ (fr & 7)) << 4, sw1 = ((4 + fq) ^ (fr & 7)) << 4;
    const bf16_t* pa[G::AI]; const bf16_t* pb[G::BI]; long pstep = 0; int pnk = 0, ps = 0, pk = 0;
    if (!segf(0, pa, pstep, pb, pnk)) return;
    bool pvalid = true;
    int cs = 0, ck = 0, cnk = pnk, nk_next = 0, ibuf = 0, cbuf = 0, inflight = 0;
    f32x4 acc[G::MT][G::NTL] = {};
    auto issue = [&]() {
        unsigned char* dst = lds + ibuf * G::STAGE;
#pragma unroll
        for (int i = 0; i < G::AI; ++i) { __builtin_amdgcn_global_load_lds((const unsigned*)pa[i], (unsigned*)(dst + (i * NT + tid) * 16), 16, 0, 0); pa[i] += pstep; }
#pragma unroll
        for (int i = 0; i < G::BI; ++i) { __builtin_amdgcn_global_load_lds((const unsigned*)pb[i], (unsigned*)(dst + G::ABYTES + (i * NT + tid) * 16), 16, 0, 0); pb[i] += 64; }
        ibuf = ibuf == 2 ? 0 : ibuf + 1; ++inflight;
        if (++pk == pnk) { ++ps; pk = 0; int nk2 = 0; pvalid = segf(ps, pa, pstep, pb, nk2); pnk = nk2; nk_next = nk2; }
    };
    __syncthreads();
    issue(); if (pvalid) issue();
    for (;;) {
        if (inflight >= 2) asm volatile("s_waitcnt vmcnt(%0)" :: "n"(NL) : "memory"); else asm volatile("s_waitcnt vmcnt(0)" ::: "memory");
        __builtin_amdgcn_s_barrier();
        --inflight;
        if (pvalid) issue();
        const unsigned char* cur = lds + cbuf * G::STAGE; cbuf = cbuf == 2 ? 0 : cbuf + 1;
#pragma unroll
        for (int ks = 0; ks < 2; ++ks) {
            const int sw = ks ? sw1 : sw0;
            bf16x8 a[G::MT], b[G::NTL];
#pragma unroll
            for (int mt = 0; mt < G::MT; ++mt) a[mt] = *(const bf16x8*)(cur + aoff + mt * 2048 + sw);
#pragma unroll
            for (int nt = 0; nt < G::NTL; ++nt) b[nt] = *(const bf16x8*)(cur + boff + nt * 2048 + sw);
            __builtin_amdgcn_s_setprio(1);
#pragma unroll
            for (int mt = 0; mt < G::MT; ++mt)
#pragma unroll
                for (int nt = 0; nt < G::NTL; ++nt) acc[mt][nt] = __builtin_amdgcn_mfma_f32_16x16x32_bf16(b[nt], a[mt], acc[mt][nt], 0, 0, 0);
            __builtin_amdgcn_s_setprio(0);
        }
        if (++ck == cnk) { epi(cs, acc); ++cs; ck = 0; cnk = nk_next; if (inflight == 0 && !pvalid) break; }
    }
}
#define ZERO_ACC(acc, MT_, NTL_) do { _Pragma("unroll") for (int _m = 0; _m < (MT_); ++_m) _Pragma("unroll") for (int _n = 0; _n < (NTL_); ++_n) acc[_m][_n] = (f32x4){0.f, 0.f, 0.f, 0.f}; } while (0)

struct U256 { const char* A; const char* B; int K; int f8; const int* gidx; int gmax; };
__device__ __forceinline__ int g256_lds_byte(int r, int c) { const int st = (r >> 4) * 2 + (c >> 5), rr = r & 15, cc = c & 31, ob = rr * 64 + cc * 2; return st * 1024 + (ob ^ (((ob >> 9) & 1) << 5)); }
__device__ __forceinline__ void g256_stage_rc(int b, int& R, int& C) { const int st = b / 1024, sb = b % 1024, swz = sb ^ (((sb >> 9) & 1) << 5); R = (st >> 1) * 16 + swz / 64; C = (st & 1) * 32 + (swz % 64) / 2; }
__device__ __forceinline__ int g256_perm32(int rho) { const int n = rho >> 4, i = rho & 15; return 8 * (i >> 2) + 4 * n + (i & 3); }
template <bool PERM = false, class NextF, class EpiF>
__device__ __forceinline__ void gemm256(unsigned char* lds_g, NextF&& next, EpiF&& epi) {
    constexpr int HTB = 128 * 64 * 2;
    LAS unsigned char* lds = (LAS unsigned char*)lds_g;
    const int tid = tidx(), wid = __builtin_amdgcn_readfirstlane(tid >> 6), lane = tid & 63, wr = wid >> 2, wc = wid & 3, fr = lane & 15, fq = lane >> 4;
    int RR[2], CC[2], RB2[2];
#pragma unroll
    for (int i = 0; i < 2; ++i) { g256_stage_rc(tid * 16 + i * 8192, RR[i], CC[i]); RB2[i] = PERM ? ((RR[i] & ~31) + g256_perm32(RR[i] & 31)) : RR[i]; }
    const size_t kstep = 128;
    const unsigned ldsw = (unsigned)wid * 1024u;
    const int aoff = g256_lds_byte(wr * 64 + fr, fq * 8), boff = g256_lds_byte(wc * 32 + fr, fq * 8);
#define G2_SA(b, h) (((b) * 2 + (h)) * HTB)
#define G2_SB(b, h) ((4 + (b) * 2 + (h)) * HTB)
#define G2_STAGE(bufoff, gbase, voff) do { _Pragma("unroll") for (int _i = 0; _i < 2; ++_i) \
        __builtin_amdgcn_global_load_lds((const unsigned*)((const char*)(gbase) + (voff)[_i]), (LAS unsigned*)(lds + (bufoff) + ldsw + _i * 8192), 16, 0, 0); } while (0)
#define G2_LDA(dst, b, h) do { _Pragma("unroll") for (int m = 0; m < 4; ++m) _Pragma("unroll") for (int k = 0; k < 2; ++k) dst[m][k] = *(const LAS bf16x8*)(lds + G2_SA(b, h) + aoff + m * 2048 + k * 1024); } while (0)
#define G2_LDB(dst, b, h) do { _Pragma("unroll") for (int n = 0; n < 2; ++n) _Pragma("unroll") for (int k = 0; k < 2; ++k) dst[n][k] = *(const LAS bf16x8*)(lds + G2_SB(b, h) + boff + n * 2048 + k * 1024); } while (0)
#define G2_MMA(ai, bj, At, Bt) do { __builtin_amdgcn_s_setprio(1); _Pragma("unroll") for (int m = 0; m < 4; ++m) _Pragma("unroll") for (int n = 0; n < 2; ++n) _Pragma("unroll") for (int k = 0; k < 2; ++k) \
        acc[ai][bj][m][n] = __builtin_amdgcn_mfma_f32_16x16x32_bf16(Bt[n][k], At[m][k], acc[ai][bj][m][n], 0, 0, 0); __builtin_amdgcn_s_setprio(0); } while (0)
#define G2_WAIT_V(n) asm volatile("s_waitcnt vmcnt(" #n ")" ::: "memory")
#define G2_WAIT_L(n) asm volatile("s_waitcnt lgkmcnt(" #n ")" ::: "memory")
#define G2_BAR __builtin_amdgcn_s_barrier()
#define G2_SCHED __builtin_amdgcn_sched_barrier(0)
#define G2_ZERO() do { _Pragma("unroll") for (int a = 0; a < 2; ++a) _Pragma("unroll") for (int b = 0; b < 2; ++b) _Pragma("unroll") for (int m = 0; m < 4; ++m) _Pragma("unroll") for (int n = 0; n < 2; ++n) acc[a][b][m][n] = (f32x4){0.f, 0.f, 0.f, 0.f}; } while (0)
    U256 cur, nxt; int ui = 0;
    if (!next(0, cur)) return;
    __syncthreads();
    f32x4 acc[2][2][4][2];
    G2_ZERO();
    bf16x8 At[4][2], B0[2][2], B1[2][2];
    unsigned vo[2], nvo[2], vob[2], nvob[2];
#pragma unroll
    for (int i = 0; i < 2; ++i) { vo[i] = (unsigned)(RR[i] * cur.K + CC[i]) * 2u; vob[i] = (unsigned)(RB2[i] * cur.K + CC[i]) * 2u; }
    size_t hstep = (size_t)128 * cur.K * 2;
    const char* cA = cur.A; const char* cB = cur.B;
    G2_STAGE(G2_SB(0, 0), cB, vob); G2_STAGE(G2_SA(0, 0), cA, vo); G2_STAGE(G2_SB(0, 1), cB + hstep, vob); G2_STAGE(G2_SA(0, 1), cA + hstep, vo);
    if (wr == 1) G2_BAR;
    G2_WAIT_V(4); G2_BAR;
    G2_STAGE(G2_SB(1, 0), cB + kstep, vob); G2_STAGE(G2_SA(1, 0), cA + kstep, vo); G2_STAGE(G2_SB(1, 1), cB + hstep + kstep, vob);
    G2_WAIT_V(6); G2_BAR;
    for (;;) {
        const bool has_next = next(ui + 1, nxt);
        const char* nA = has_next ? nxt.A : cA; const char* nB = has_next ? nxt.B : cB; const int nK = has_next ? nxt.K : cur.K;
#pragma unroll
        for (int i = 0; i < 2; ++i) { nvo[i] = (unsigned)(RR[i] * nK + CC[i]) * 2u; nvob[i] = (unsigned)(RB2[i] * nK + CC[i]) * 2u; }
        const size_t nh = (size_t)128 * nK * 2;
        const int nt = cur.K >> 6;
        for (int t = 0; t < nt; t += 2) {
            const bool last = (t == nt - 2);
            const char* a1 = cA + (size_t)(t + 1) * kstep;
            const char* a2 = last ? nA : cA + (size_t)(t + 2) * kstep; const char* b2 = last ? nB : cB + (size_t)(t + 2) * kstep;
            const char* a3 = a2 + kstep; const char* b3 = b2 + kstep;
            unsigned v2[2], v2b[2]; v2[0] = last ? nvo[0] : vo[0]; v2[1] = last ? nvo[1] : vo[1]; v2b[0] = last ? nvob[0] : vob[0]; v2b[1] = last ? nvob[1] : vob[1];
            const size_t h2 = last ? nh : hstep;
            G2_LDB(B0, 0, 0); G2_SCHED; G2_LDA(At, 0, 0); G2_STAGE(G2_SA(1, 1), a1 + hstep, vo);
            G2_WAIT_L(8); G2_BAR; G2_WAIT_L(0); G2_MMA(0, 0, At, B0); G2_BAR; G2_SCHED;
            G2_LDB(B1, 0, 1); G2_STAGE(G2_SB(0, 0), b2, v2b);
            G2_BAR; G2_WAIT_L(0); G2_MMA(0, 1, At, B1); G2_BAR;
            G2_LDA(At, 0, 1); G2_STAGE(G2_SA(0, 0), a2, v2);
            G2_BAR; G2_WAIT_L(0); G2_MMA(1, 0, At, B0); G2_BAR; G2_SCHED;
            G2_STAGE(G2_SB(0, 1), b2 + h2, v2b);
            G2_WAIT_V(6); G2_BAR; G2_MMA(1, 1, At, B1); G2_BAR;
            G2_LDB(B0, 1, 0); G2_SCHED; G2_LDA(At, 1, 0); G2_STAGE(G2_SA(0, 1), a2 + h2, v2);
            G2_WAIT_L(8); G2_BAR; G2_WAIT_L(0); G2_MMA(0, 0, At, B0); G2_BAR; G2_SCHED;
            G2_LDB(B1, 1, 1); G2_STAGE(G2_SB(1, 0), b3, v2b);
            G2_BAR; G2_WAIT_L(0); G2_MMA(0, 1, At, B1); G2_BAR;
            G2_LDA(At, 1, 1); G2_STAGE(G2_SA(1, 0), a3, v2);
            G2_BAR; G2_WAIT_L(0); G2_MMA(1, 0, At, B0); G2_BAR; G2_SCHED;
            G2_STAGE(G2_SB(1, 1), b3 + h2, v2b);
            G2_WAIT_V(6); G2_BAR; G2_MMA(1, 1, At, B1); G2_BAR;
        }
        epi(ui, acc, wr, wc, fr, fq);
        if (!has_next) break;
        G2_ZERO();
        cur = nxt; cA = nA; cB = nB; vo[0] = nvo[0]; vo[1] = nvo[1]; vob[0] = nvob[0]; vob[1] = nvob[1]; hstep = nh; ++ui;
    }
    G2_WAIT_V(0);
    if (wr == 0) G2_BAR;
    G2_BAR;
#undef G2_SA
#undef G2_SB
#undef G2_STAGE
#undef G2_LDA
#undef G2_LDB
#undef G2_MMA
#undef G2_WAIT_V
#undef G2_WAIT_L
#undef G2_BAR
#undef G2_SCHED
#undef G2_ZERO
}
template <class NextF, class EpiF>
__device__ __forceinline__ void gemm256h3(unsigned char* lds_g, NextF&& next, EpiF&& epi) {
    constexpr unsigned HTB = 128 * 64 * 2, BUFB = 3 * HTB;
    LAS unsigned char* lds = (LAS unsigned char*)lds_g;
    const int tid = tidx(), wid = __builtin_amdgcn_readfirstlane(tid >> 6), lane = tid & 63, wr = wid >> 2, wc = wid & 3, fr = lane & 15, fq = lane >> 4;
    int RR[2], CC[2];
#pragma unroll
    for (int i = 0; i < 2; ++i) g256_stage_rc(tid * 16 + i * 8192, RR[i], CC[i]);
    const size_t kstep = 128;
    const unsigned ldsw = (unsigned)wid * 1024u;
    const unsigned aoff = g256_lds_byte(wr * 64 + fr, fq * 8), boff = g256_lds_byte(wc * 32 + fr, fq * 8) + 2 * HTB;
#define H3_STAGE(bufoff, gbase, voff) do { _Pragma("unroll") for (int _i = 0; _i < 2; ++_i) \
        __builtin_amdgcn_global_load_lds((const unsigned*)((const char*)(gbase) + (voff)[_i]), (LAS unsigned*)(lds + (bufoff) + ldsw + _i * 8192), 16, 0, 0); } while (0)
#define H3_LDA(dst, bo, h) do { _Pragma("unroll") for (int m = 0; m < 4; ++m) _Pragma("unroll") for (int k = 0; k < 2; ++k) dst[m][k] = *(const LAS bf16x8*)(lds + (bo) + aoff + (h) * HTB + m * 2048 + k * 1024); } while (0)
#define H3_LDB(dst, bo) do { _Pragma("unroll") for (int n = 0; n < 2; ++n) _Pragma("unroll") for (int k = 0; k < 2; ++k) dst[n][k] = *(const LAS bf16x8*)(lds + (bo) + boff + n * 2048 + k * 1024); } while (0)
#define H3_MMA(ai, At, Bt) do { __builtin_amdgcn_s_setprio(1); _Pragma("unroll") for (int m = 0; m < 4; ++m) _Pragma("unroll") for (int n = 0; n < 2; ++n) _Pragma("unroll") for (int k = 0; k < 2; ++k) \
        acc[ai][m][n] = __builtin_amdgcn_mfma_f32_16x16x32_bf16(Bt[n][k], At[m][k], acc[ai][m][n], 0, 0, 0); __builtin_amdgcn_s_setprio(0); } while (0)
#define H3_MMA8(ai, At, Bt) do { __builtin_amdgcn_s_setprio(1); _Pragma("unroll") for (int m = 0; m < 4; ++m) _Pragma("unroll") for (int n = 0; n < 2; ++n) { \
        const i32x4 a0 = __builtin_bit_cast(i32x4, At[m][0]), a1 = __builtin_bit_cast(i32x4, At[m][1]), b0 = __builtin_bit_cast(i32x4, Bt[n][0]), b1 = __builtin_bit_cast(i32x4, Bt[n][1]); \
        const i32x8 av = __builtin_shufflevector(a0, a1, 0, 1, 2, 3, 4, 5, 6, 7), bv = __builtin_shufflevector(b0, b1, 0, 1, 2, 3, 4, 5, 6, 7); \
        acc[ai][m][n] = __builtin_amdgcn_mfma_scale_f32_16x16x128_f8f6f4(bv, av, acc[ai][m][n], 0, 0, 0, 0x7F7F7F7F, 0, 0x7F7F7F7F); } __builtin_amdgcn_s_setprio(0); } while (0)
#define H3_WAIT_V(n) asm volatile("s_waitcnt vmcnt(" #n ")" ::: "memory")
#define H3_WAIT_L(n) asm volatile("s_waitcnt lgkmcnt(" #n ")" ::: "memory")
#define H3_BAR __builtin_amdgcn_s_barrier()
#define H3_SCHED __builtin_amdgcn_sched_barrier(0)
#define H3_ZERO() do { _Pragma("unroll") for (int a = 0; a < 2; ++a) _Pragma("unroll") for (int m = 0; m < 4; ++m) _Pragma("unroll") for (int n = 0; n < 2; ++n) acc[a][m][n] = (f32x4){0.f, 0.f, 0.f, 0.f}; } while (0)
#define H3_KLOOP(MMA_) \
        for (int t = 0; t < nt; ++t) { \
            const int t2 = t + 2; const bool wrap = t2 >= nt; \
            const char* sa = wrap ? nA + (size_t)(t2 - nt) * kstep : cA + (size_t)t2 * kstep; \
            const char* sb = wrap ? nB + (size_t)(t2 - nt) * kstep : cB + (size_t)t2 * kstep; \
            unsigned sv[2]; sv[0] = wrap ? nvo[0] : vo[0]; sv[1] = wrap ? nvo[1] : vo[1]; \
            const size_t sh = wrap ? nh : hstep; \
            H3_LDB(B0, bc); H3_SCHED; H3_LDA(At, bc, 0); H3_STAGE(bp + 2 * HTB, sb, sv); H3_STAGE(bp, sa, sv); \
            H3_WAIT_V(10); H3_BAR; H3_WAIT_L(0); MMA_(0, At, B0); H3_BAR; H3_SCHED; \
            H3_LDA(At, bc, 1); H3_STAGE(bp + HTB, sa + sh, sv); \
            H3_WAIT_V(8); H3_BAR; H3_WAIT_L(0); MMA_(1, At, B0); H3_BAR; H3_SCHED; \
            const unsigned tb = bc; bc = bn; bn = bp; bp = tb; \
        }
    U256 cur, nxt; int ui = 0;
    if (!next(0, cur)) return;
    __syncthreads();
    f32x4 acc[2][4][2];
    H3_ZERO();
    bf16x8 At[4][2], B0[2][2];
    unsigned vo[2], nvo[2];
#pragma unroll
    for (int i = 0; i < 2; ++i) vo[i] = (unsigned)(RR[i] * cur.K + CC[i]) * 2u;
    size_t hstep = (size_t)128 * cur.K * 2;
    const char* cA = cur.A; const char* cB = cur.B;
    unsigned bc = 0, bn = BUFB, bp = 2 * BUFB;
    H3_STAGE(bc + 2 * HTB, cB, vo); H3_STAGE(bc, cA, vo); H3_STAGE(bc + HTB, cA + hstep, vo);
    H3_STAGE(bn + 2 * HTB, cB + kstep, vo); H3_STAGE(bn, cA + kstep, vo); H3_STAGE(bn + HTB, cA + hstep + kstep, vo);
    if (wr == 1) H3_BAR;
    H3_WAIT_V(8); H3_BAR;
    H3_BAR;
    for (;;) {
        const bool has_next = next(ui + 1, nxt);
        const char* nA = has_next ? nxt.A : cA; const char* nB = has_next ? nxt.B : cB; const int nK = has_next ? nxt.K : cur.K;
#pragma unroll
        for (int i = 0; i < 2; ++i) nvo[i] = (unsigned)(RR[i] * nK + CC[i]) * 2u;
        const size_t nh = (size_t)128 * nK * 2;
        const int nt = cur.K >> 6; const bool f8 = cur.f8 != 0;
        if (f8) { H3_KLOOP(H3_MMA8) } else { H3_KLOOP(H3_MMA) }
        epi(ui, acc, wr, wc, fr, fq);
        if (!has_next) break;
        H3_ZERO();
        cur = nxt; cA = nA; cB = nB; vo[0] = nvo[0]; vo[1] = nvo[1]; hstep = nh; ++ui;
    }
    H3_WAIT_V(0);
    if (wr == 0) H3_BAR;
    H3_BAR;
#undef H3_STAGE
#undef H3_LDA
#undef H3_LDB
#undef H3_MMA
#undef H3_MMA8
#undef H3_KLOOP
#undef H3_WAIT_V
#undef H3_WAIT_L
#undef H3_BAR
#undef H3_SCHED
#undef H3_ZERO
}
template <class NextF, class EpiF>
__device__ __forceinline__ void gemm256h3g(unsigned char* lds_g, NextF&& next, EpiF&& epi) {
    constexpr unsigned HTB = 128 * 64 * 2, BUFB = 3 * HTB;
    LAS unsigned char* lds = (LAS unsigned char*)lds_g;
    const int tid = tidx(), wid = __builtin_amdgcn_readfirstlane(tid >> 6), lane = tid & 63, wr = wid >> 2, wc = wid & 3, fr = lane & 15, fq = lane >> 4;
    int RR[2], CC[2];
#pragma unroll
    for (int i = 0; i < 2; ++i) g256_stage_rc(tid * 16 + i * 8192, RR[i], CC[i]);
    const size_t kstep = 128;
    const unsigned ldsw = (unsigned)wid * 1024u;
    const unsigned aoff = g256_lds_byte(wr * 64 + fr, fq * 8), boff = g256_lds_byte(wc * 32 + fr, fq * 8) + 2 * HTB;
#define H3_STAGE(bufoff, gbase, voff) do { _Pragma("unroll") for (int _i = 0; _i < 2; ++_i) \
        __builtin_amdgcn_global_load_lds((const unsigned*)((const char*)(gbase) + (voff)[_i]), (LAS unsigned*)(lds + (bufoff) + ldsw + _i * 8192), 16, 0, 0); } while (0)
#define H3_LDA(dst, bo, h) do { _Pragma("unroll") for (int m = 0; m < 4; ++m) _Pragma("unroll") for (int k = 0; k < 2; ++k) dst[m][k] = *(const LAS bf16x8*)(lds + (bo) + aoff + (h) * HTB + m * 2048 + k * 1024); } while (0)
#define H3_LDB(dst, bo) do { _Pragma("unroll") for (int n = 0; n < 2; ++n) _Pragma("unroll") for (int k = 0; k < 2; ++k) dst[n][k] = *(const LAS bf16x8*)(lds + (bo) + boff + n * 2048 + k * 1024); } while (0)
#define H3_MMA(ai, At, Bt) do { __builtin_amdgcn_s_setprio(1); _Pragma("unroll") for (int m = 0; m < 4; ++m) _Pragma("unroll") for (int n = 0; n < 2; ++n) { \
        const i32x4 a0 = __builtin_bit_cast(i32x4, At[m][0]), a1 = __builtin_bit_cast(i32x4, At[m][1]), b0 = __builtin_bit_cast(i32x4, Bt[n][0]), b1 = __builtin_bit_cast(i32x4, Bt[n][1]); \
        const i32x8 av = __builtin_shufflevector(a0, a1, 0, 1, 2, 3, 4, 5, 6, 7), bv = __builtin_shufflevector(b0, b1, 0, 1, 2, 3, 4, 5, 6, 7); \
        acc[ai][m][n] = __builtin_amdgcn_mfma_scale_f32_16x16x128_f8f6f4(av, bv, acc[ai][m][n], 0, 0, 0, 0x7F7F7F7F, 0, 0x7F7F7F7F); } __builtin_amdgcn_s_setprio(0); } while (0)
#define H3_WAIT_V(n) asm volatile("s_waitcnt vmcnt(" #n ")" ::: "memory")
#define H3_WAIT_L(n) asm volatile("s_waitcnt lgkmcnt(" #n ")" ::: "memory")
#define H3_BAR __builtin_amdgcn_s_barrier()
#define H3_SCHED __builtin_amdgcn_sched_barrier(0)
#define H3_ZERO() do { _Pragma("unroll") for (int a = 0; a < 2; ++a) _Pragma("unroll") for (int m = 0; m < 4; ++m) _Pragma("unroll") for (int n = 0; n < 2; ++n) acc[a][m][n] = (f32x4){0.f, 0.f, 0.f, 0.f}; } while (0)
#define H3_KLOOP(MMA_) \
        _Pragma("unroll 1") for (int t = 0; t < nt; ++t) { \
            if (t == 2) { _Pragma("unroll") for (int i = 0; i < 2; ++i) nvob[i] = (unsigned)(gix[RR[i]] * nK + CC[i]) * 2u; } \
            const int t2 = t + 2; const bool wrap = t2 >= nt; \
            const char* sa = wrap ? nA + (size_t)(t2 - nt) * kstep : cA + (size_t)t2 * kstep; \
            const char* sb = wrap ? nB + (size_t)(t2 - nt) * kstep : cB + (size_t)t2 * kstep; \
            unsigned sv[2], svb[2]; sv[0] = wrap ? nvo[0] : vo[0]; sv[1] = wrap ? nvo[1] : vo[1]; svb[0] = wrap ? nvob[0] : vob[0]; svb[1] = wrap ? nvob[1] : vob[1]; \
            const size_t sh = wrap ? nh : hstep; \
            H3_LDB(B0, bc); H3_SCHED; H3_LDA(At, bc, 0); H3_STAGE(bp + 2 * HTB, sb, svb); H3_STAGE(bp, sa, sv); \
            H3_WAIT_V(10); H3_BAR; H3_WAIT_L(0); MMA_(0, At, B0); H3_BAR; H3_SCHED; \
            H3_LDA(At, bc, 1); H3_STAGE(bp + HTB, sa + sh, sv); \
            H3_WAIT_V(8); H3_BAR; H3_WAIT_L(0); MMA_(1, At, B0); H3_BAR; H3_SCHED; \
            const unsigned tb = bc; bc = bn; bn = bp; bp = tb; \
        }
    U256 cur, nxt; int ui = 0;
    if (!next(0, cur)) return;
    __syncthreads();
    f32x4 acc[2][4][2];
    H3_ZERO();
    bf16x8 At[4][2], B0[2][2];
    unsigned vo[2], nvo[2], vob[2], nvob[2] = {0u, 0u};
    const LAS int* gix = (const LAS int*)(lds + 149504);
#pragma unroll
    for (int i = 0; i < 2; ++i) { vo[i] = (unsigned)(RR[i] * cur.K + CC[i]) * 2u; const int r = RR[i] < cur.gmax ? RR[i] : cur.gmax - 1; vob[i] = (unsigned)(cur.gidx[r] * cur.K + CC[i]) * 2u; }
    size_t hstep = (size_t)128 * cur.K * 2;
    const char* cA = cur.A; const char* cB = cur.B;
    unsigned bc = 0, bn = BUFB, bp = 2 * BUFB;
    H3_STAGE(bc + 2 * HTB, cB, vob); H3_STAGE(bc, cA, vo); H3_STAGE(bc + HTB, cA + hstep, vo);
    H3_STAGE(bn + 2 * HTB, cB + kstep, vob); H3_STAGE(bn, cA + kstep, vo); H3_STAGE(bn + HTB, cA + hstep + kstep, vo);
    if (wr == 1) H3_BAR;
    H3_WAIT_V(8); H3_BAR;
    H3_BAR;
    for (;;) {
        const bool has_next = next(ui + 1, nxt);
        const char* nA = has_next ? nxt.A : cA; const char* nB = has_next ? nxt.B : cB; const int nK = has_next ? nxt.K : cur.K;
#pragma unroll
        for (int i = 0; i < 2; ++i) nvo[i] = (unsigned)(RR[i] * nK + CC[i]) * 2u;
        const size_t nh = (size_t)128 * nK * 2;
        int nt = cur.K >> 6; asm volatile("" : "+s"(nt));
        if (wid < 2) { const int gm = has_next ? nxt.gmax : cur.gmax, li = wid * 64 + lane; const int* gsrc = (has_next ? nxt.gidx : cur.gidx) + (li < gm ? li : gm - 1);
            __builtin_amdgcn_global_load_lds((const unsigned*)gsrc, (LAS unsigned*)(lds + 149504 + wid * 256), 4, 0, 0); }
        H3_KLOOP(H3_MMA)
        epi(ui, acc, wr, wc, fr, fq);
        if (!has_next) break;
        H3_ZERO();
        cur = nxt; cA = nA; cB = nB; vo[0] = nvo[0]; vo[1] = nvo[1]; vob[0] = nvob[0]; vob[1] = nvob[1]; hstep = nh; ++ui;
    }
    H3_WAIT_V(0);
    if (wr == 0) H3_BAR;
    H3_BAR;
#undef H3_STAGE
#undef H3_LDA
#undef H3_LDB
#undef H3_MMA
#undef H3_KLOOP
#undef H3_WAIT_V
#undef H3_WAIT_L
#undef H3_BAR
#undef H3_SCHED
#undef H3_ZERO
}

template <int NTL, int KS>
__device__ __forceinline__ void wave_mma(f32x4 (&acc)[NTL], const unsigned char* a, int lda, const unsigned char* b, int ldb) {
    const int lane = tidx() & 63, fr = lane & 15, fq = lane >> 4;
#pragma unroll
    for (int ks = 0; ks < KS; ++ks) {
        const bf16x8 af = *(const bf16x8*)(a + fr * lda + ks * 64 + fq * 16);
#pragma unroll
        for (int nt = 0; nt < NTL; ++nt) {
            const bf16x8 bf = *(const bf16x8*)(b + (nt * 16 + fr) * ldb + ks * 64 + fq * 16);
            acc[nt] = __builtin_amdgcn_mfma_f32_16x16x32_bf16(af, bf, acc[nt], 0, 0, 0);
        }
    }
}

template <int NTL, int KS>
__device__ __forceinline__ void wave_mma_t(f32x4 (&acc)[NTL], const unsigned char* a, int lda, const unsigned char* b, int ldb) {
    const int lane = tidx() & 63, fr = lane & 15, fq = lane >> 4;
#pragma unroll
    for (int ks = 0; ks < KS; ++ks) {
        const bf16x8 af = *(const bf16x8*)(a + fr * lda + ks * 64 + fq * 16);
#pragma unroll
        for (int nt = 0; nt < NTL; ++nt) {
            const bf16x8 bf = *(const bf16x8*)(b + (nt * 16 + fr) * ldb + ks * 64 + fq * 16);
            acc[nt] = __builtin_amdgcn_mfma_f32_16x16x32_bf16(bf, af, acc[nt], 0, 0, 0);
        }
    }
}

__device__ __forceinline__ void unit_mod(KP p, int u) {
    const int l = u / 96, j0 = (u % 96) * 64, tid = tidx();
    float* act = (float*)smem;
    float* red = act + 5 * 1024;
    __syncthreads();
    for (int i = tid; i < 5 * 1024; i += NT) { const int v = i >> 10, k = i & 1023; const float c = v < 4 ? p->in[1][v * 1024 + k] : p->in[3][k]; act[i] = c / (1.f + expf(-c)); }
    __syncthreads();
    const int col = tid & 63, ks = tid >> 6;
    const float* w = p->in[6] + (size_t)l * 1024 * 6144 + j0 + col;
    float a0 = 0, a1 = 0, a2 = 0, a3 = 0, a4 = 0;
#pragma unroll 16
    for (int k = ks * 128; k < ks * 128 + 128; ++k) { const float wv = w[(size_t)k * 6144]; a0 += act[k] * wv; a1 += act[1024 + k] * wv; a2 += act[2048 + k] * wv; a3 += act[3072 + k] * wv; a4 += act[4096 + k] * wv; }
    red[(ks * 5 + 0) * 64 + col] = a0; red[(ks * 5 + 1) * 64 + col] = a1; red[(ks * 5 + 2) * 64 + col] = a2; red[(ks * 5 + 3) * 64 + col] = a3; red[(ks * 5 + 4) * 64 + col] = a4;
    __syncthreads();
    if (tid < 320) { const int v = tid >> 6, c = tid & 63; float s = 0.f;
        for (int k = 0; k < 8; ++k) s += red[(k * 5 + v) * 64 + c];
        ((float*)(p->ws + WS_MOD))[((size_t)l * 5 + v) * 6144 + j0 + c] = s + p->in[7][l * 6144 + j0 + c]; }
}
__device__ __forceinline__ void unit_tables(KP p, int u) {
    const int tid = tidx();
    if (u == 0) {
        bf16_t* gw = (bf16_t*)(p->ws + WS_GWB);
#pragma unroll 6
        for (int i = tid; i < 2 * 4 * 128 * 40; i += NT) { const int k = i % 40, n = (i / 40) & 127, hh = (i / 5120) & 3, l = i / 20480, d = n >> 6, dk = n & 63;
            gw[i] = (k < 32 && (k >> 4) == d) ? (bf16_t)f2bf(p->in[22][(((size_t)l * 2 + d) * 16 + (k & 15)) * 256 + hh * 64 + dk]) : (bf16_t)0; }
        float* t = (float*)(p->ws + WS_ROPE);
#pragma unroll 6
        for (int i = tid; i < 192 * 16; i += NT) {
            const int pos = i >> 4, f = i & 15; const double inv = (double)exp2f(-(float)f * (13.287712379549449f / 16.f));
            const double rev = (double)(pos < 128 ? pos : pos - 128) * inv * 0.15915494309189535;
            const float fr = (float)(rev - rint(rev)); const float c = __builtin_amdgcn_cosf(fr), s = __builtin_amdgcn_sinf(fr);
            if (pos < 128) { t[pos * 16 + f] = c; t[2048 + pos * 16 + f] = s; } else { t[4096 + (pos - 128) * 16 + f] = c; t[4096 + 1024 + (pos - 128) * 16 + f] = s; }
        }
    } else {
        const int l = (u - 1) / 4, part = (u - 1) % 4;
        float* wr = (float*)(p->ws + WS_WR) + (size_t)l * 36 * 1024;
#pragma unroll 6
        for (int i = part * 9216 + tid; i < part * 9216 + 9216; i += NT) { const int o = i >> 10, k = i & 1023;
            wr[i] = o < 4 ? p->in[33][((size_t)l * 1024 + k) * 4 + o] : p->in[35][((size_t)l * 1024 + k) * 32 + (o - 4)]; }
    }
}
__device__ __forceinline__ void unit_s5w(KP p, int u) {
    const int l = u >> 4, g = u & 15, tid = tidx();
    float2* pw = (float2*)smem;
    float2* bb = pw + 2 * 17 * 64;
    float2* cc = bb + 2 * 64 * 16;
    float* mt = (float*)(cc + 2 * 16 * 64);
    __syncthreads();
    for (int i = tid; i < 2 * 17 * 64; i += NT) {
        const int d = i / (17 * 64), t = (i >> 6) % 17, pi = i & 63; const size_t gi = (((size_t)l * 2 + d) * 16 + g);
        const float lr = p->in[11][gi * 64 + pi], li = p->in[12][gi * 64 + pi]; const double dt = exp((double)p->in[13][gi]);
        const double rev = (double)li * dt * t * 0.15915494309189535; const float fr = (float)(rev - rint(rev));
        const float mg = expf((float)((double)lr * dt * t)); const float2 a = make_float2(mg * __builtin_amdgcn_cosf(fr), mg * __builtin_amdgcn_sinf(fr));
        pw[i] = a;
        if (t == 16) ((float2*)(p->ws + WS_A16))[gi * 64 + pi] = a;
    }
    float2* crci = (float2*)(mt + 2 * 16 * 16 * 16);
    if (tid < 128) {
        const int d = tid >> 6, pi = tid & 63; const size_t gi = (((size_t)l * 2 + d) * 16 + g);
        const double lr = p->in[11][gi * 64 + pi], li = p->in[12][gi * 64 + pi], dt = exp((double)p->in[13][gi]);
        const double mg = exp(lr * dt), ar = mg * cos(li * dt), ai = mg * sin(li * dt), den = lr * lr + li * li, nr = ar - 1.0, ni = ai;
        crci[tid] = make_float2((float)((nr * lr + ni * li) / den), (float)((ni * lr - nr * li) / den));
    }
    __syncthreads();
    for (int i = tid; i < 2 * 64 * 16; i += NT) {
        const int d = i >> 10, pi = (i >> 4) & 63, h = i & 15; const size_t gi = (((size_t)l * 2 + d) * 16 + g);
        const float2 c = crci[d * 64 + pi];
        const float br = p->in[14][(gi * 64 + pi) * 16 + h], bi = p->in[15][(gi * 64 + pi) * 16 + h];
        bb[i] = make_float2(c.x * br - c.y * bi, c.x * bi + c.y * br);
    }
    for (int i = tid; i < 2 * 16 * 64; i += NT) { const int d = i >> 10, h = (i >> 6) & 15, pi = i & 63; const size_t gi = (((size_t)l * 2 + d) * 16 + g);
        cc[i] = make_float2(p->in[16][(gi * 16 + h) * 64 + pi], p->in[17][(gi * 16 + h) * 64 + pi]); }
    __syncthreads();
    for (int i = tid; i < 2 * 16 * 16 * 16; i += NT) {
        const int d = i >> 12, tau = (i >> 8) & 15, h = (i >> 4) & 15, h2 = i & 15; float s = 0.f;
        for (int pi = 0; pi < 64; ++pi) { const float2 c = cc[(d * 16 + h) * 64 + pi], a = pw[(d * 17 + tau) * 64 + pi], b = bb[(d * 64 + pi) * 16 + h2];
            const float xr = c.x * a.x - c.y * a.y, xi = c.x * a.y + c.y * a.x; s += xr * b.x - xi * b.y; }
        mt[i] = s;
    }
    __syncthreads();
    bf16_t* w1 = (bf16_t*)(p->ws + WS_S5W1) + (size_t)u * 512 * 256;
    bf16_t* w2 = (bf16_t*)(p->ws + WS_S5W2) + (size_t)u * 256 * 256;
    for (int i = tid; i < 256 * 256; i += NT) {
        const int n = i >> 8, k = i & 255, s = n >> 4, h = n & 15, s2 = k >> 4, h2 = k & 15; float v = 0.f;
        if (s2 <= s) v += mt[((0 * 16 + (s - s2)) * 16 + h) * 16 + h2];
        if (s2 >= s) v += mt[((1 * 16 + (s2 - s)) * 16 + h) * 16 + h2];
        if (n == k) v += p->in[18][l * 256 + g * 16 + h];
        w1[i] = (bf16_t)f2bf(v);
    }
    for (int i = tid; i < 256 * 256; i += NT) {
        const int n = i >> 8, k = i & 255, d = n >> 7, part = (n >> 6) & 1, pi = n & 63, s2 = k >> 4, h2 = k & 15, e = d == 0 ? 15 - s2 : s2;
        const float2 a = pw[(d * 17 + e) * 64 + pi], b = bb[(d * 64 + pi) * 16 + h2];
        w1[256 * 256 + i] = (bf16_t)f2bf(part == 0 ? a.x * b.x - a.y * b.y : a.x * b.y + a.y * b.x);
    }
    for (int i = tid; i < 256 * 256; i += NT) {
        const int n = i >> 8, k = i & 255, s = n >> 4, h = n & 15, d = k >> 7, part = (k >> 6) & 1, pi = k & 63, e = d == 0 ? s + 1 : 16 - s;
        const float2 c = cc[(d * 16 + h) * 64 + pi], a = pw[(d * 17 + e) * 64 + pi];
        w2[i] = (bf16_t)f2bf(part == 0 ? c.x * a.x - c.y * a.y : -(c.x * a.y + c.y * a.x));
    }
}
constexpr int CV_TILES = 800 + 1024 + 256 + 16 + 64 + 128 + 64 + 64 + 2048 * 3;
__device__ __forceinline__ void wave_convert(KP p, int layer, int t) {
    const float* src; int ld, K, ncols, ctiles; size_t dst; int grp = 1 << 30, gstride = 0, row0 = 0; bool zpad = false, wg8 = false, w13 = false;
    if (t < 800) { src = p->in[8] + (size_t)layer * 1024 * 7200; ld = 7200; K = 1024; ncols = 3104; ctiles = 50; dst = WT_WIN; zpad = true; }
    else if ((t -= 800) < 1024) { src = p->in[8] + (size_t)layer * 1024 * 7200 + 3104; ld = 7200; K = 1024; ncols = 4096; ctiles = 64; dst = WT_WG; wg8 = true; }
    else if ((t -= 1024) < 256) { src = p->in[10] + (size_t)layer * 1024 * 1024; ld = 1024; K = 1024; ncols = 1024; ctiles = 16; dst = WT_WMIX; }
    else if ((t -= 256) < 16) { src = p->in[19] + (size_t)layer * 256 * 256; ld = 256; K = 256; ncols = 256; ctiles = 4; dst = WT_WGLU; }
    else if ((t -= 16) < 64) { src = p->in[21] + (size_t)layer * 256 * 1024; ld = 1024; K = 256; ncols = 1024; ctiles = 16; dst = WT_WS5O; }
    else if ((t -= 64) < 128) { src = p->in[25] + (size_t)layer * 512 * 1024; ld = 1024; K = 512; ncols = 1024; ctiles = 16; dst = WT_WGLAO; }
    else if ((t -= 128) < 64) { src = p->in[27] + (size_t)layer * 256 * 1024; ld = 1024; K = 256; ncols = 1024; ctiles = 16; dst = WT_WNAO; }
    else if ((t -= 64) < 64) { src = p->in[32] + (size_t)layer * 256 * 1024; ld = 1024; K = 256; ncols = 1024; ctiles = 16; dst = WT_WCVO; }
    else if ((t -= 64) < 2048) { const int e = t >> 6; t &= 63; src = p->in[37] + ((size_t)layer * 32 + e) * 1024 * 256; ld = 256; K = 1024; ncols = 256; ctiles = 4; dst = WT_W13 + (size_t)e * 512 * 1024; grp = 128; gstride = 256; row0 = 0; w13 = true; }
    else if ((t -= 2048) < 2048) { const int e = t >> 6; t &= 63; src = p->in[38] + ((size_t)layer * 32 + e) * 1024 * 256; ld = 256; K = 1024; ncols = 256; ctiles = 4; dst = WT_W13 + (size_t)e * 512 * 1024; grp = 128; gstride = 256; row0 = 128; w13 = true; }
    else { t -= 2048; const int e = t >> 6; t &= 63; src = p->in[39] + ((size_t)layer * 32 + e) * 256 * 1024; ld = 1024; K = 256; ncols = 1024; ctiles = 16; dst = WT_W2 + (size_t)e * 1024 * 256; }
    const int ct = t % ctiles, kt = t / ctiles, c0 = ct * 64, k0 = kt * 64, lane = tidx() & 63, wave = tidx() >> 6;
    float* tile = (float*)smem + wave * (64 * 65);
    asm volatile("s_waitcnt lgkmcnt(0)" ::: "memory");
    float4 v[16];
#pragma unroll
    for (int ps = 0; ps < 16; ++ps) { const int kk = ps * 4 + (lane >> 4), cq = (lane & 15) * 4;
        v[ps] = (c0 + cq < ncols) ? *(const float4*)(src + (size_t)(k0 + kk) * ld + c0 + cq) : make_float4(0.f, 0.f, 0.f, 0.f); }
#pragma unroll
    for (int ps = 0; ps < 16; ++ps) { const int kk = ps * 4 + (lane >> 4), cq = (lane & 15) * 4;
        tile[kk * 65 + cq] = v[ps].x; tile[kk * 65 + cq + 1] = v[ps].y; tile[kk * 65 + cq + 2] = v[ps].z; tile[kk * 65 + cq + 3] = v[ps].w; }
    asm volatile("s_waitcnt lgkmcnt(0)" ::: "memory");
    const int k8 = (lane & 7) * 8;
#pragma unroll
    for (int ps = 0; ps < 8; ++ps) { const int cc = ps * 8 + (lane >> 3), c = c0 + cc;
        if (c < ncols || zpad) {
            const int row = row0 + (c / grp) * gstride + (c % grp);
            if (w13 || wg8) {
                uint2 o8; o8.x = f8x4(32.f * tile[(k8 + 0) * 65 + cc], 32.f * tile[(k8 + 1) * 65 + cc], 32.f * tile[(k8 + 2) * 65 + cc], 32.f * tile[(k8 + 3) * 65 + cc]);
                o8.y = f8x4(32.f * tile[(k8 + 4) * 65 + cc], 32.f * tile[(k8 + 5) * 65 + cc], 32.f * tile[(k8 + 6) * 65 + cc], 32.f * tile[(k8 + 7) * 65 + cc]);
                unsigned char* d8 = w13 ? (unsigned char*)((bf16_t*)(p->ws + WS_WT) + WT_W13) + (dst - WT_W13) : p->ws + WS_WG8;
                *(uint2*)(d8 + (size_t)row * 1024 + k0 + k8) = o8; }
            if (!w13) {
            uint4 o; o.x = pk2(tile[(k8 + 0) * 65 + cc], tile[(k8 + 1) * 65 + cc]); o.y = pk2(tile[(k8 + 2) * 65 + cc], tile[(k8 + 3) * 65 + cc]);
            o.z = pk2(tile[(k8 + 4) * 65 + cc], tile[(k8 + 5) * 65 + cc]); o.w = pk2(tile[(k8 + 6) * 65 + cc], tile[(k8 + 7) * 65 + cc]);
            *(uint4*)((bf16_t*)(p->ws + WS_WT) + dst + (size_t)row * K + k0 + k8) = o; } } }
}

__device__ __forceinline__ void phase_norm(KP p, int layer, int which, int u, int nu, bool live = true) {
    const int wave = tidx() >> 6, lane = tidx() & 63;
    const float* g = p->in[which ? 5 : 4] + layer * D;
    bf16_t* H = (bf16_t*)(p->ws + WS_HKV);
    if (which == 1) {
        const char* wsrc = (const char*)((const float*)(p->ws + WS_WR) + (size_t)layer * 36 * 1024) + lane * 16;
        __syncthreads();
#pragma unroll
        for (int k = 0; k < 18; ++k)
            __builtin_amdgcn_global_load_lds((const unsigned*)(wsrc + (k * 8 + wave) * 1024), (LAS unsigned*)((LAS unsigned char*)smem + (k * 8 + wave) * 1024), 16, 0, 0);
        asm volatile("s_waitcnt vmcnt(0)" ::: "memory");
        __syncthreads();
    }
    for (int r4 = u * 8 + wave; r4 < R / 4; r4 += nu * 8) {
        const int rbase = r4 * 4;
        const bool isctx = (rbase % RB) < CTX;
        if (isctx && which == 1 && layer == 1) continue;
        const float* mv = mod_vec(p, layer, rbase) + (which ? 3072 : 0);
        float4 h[4][4];
#pragma unroll
        for (int rr = 0; rr < 4; ++rr) {
            float ss = 0.f;
            if (!isctx && (which == 1 || layer == 1)) {
                const uint2* xr = (const uint2*)xb_row(p, rbase + rr);
#pragma unroll
                for (int i = 0; i < 4; ++i) { const float4 v = bf4(xr[lane + 64 * i]); h[rr][i] = v; ss += v.x * v.x + v.y * v.y + v.z * v.z + v.w * v.w; }
            } else {
                const float* xr = which ? (const float*)xdst_row(p, rbase + rr) : xsrc_row(p, layer, rbase + rr);
#pragma unroll
                for (int i = 0; i < 4; ++i) { const float4 v = ((const float4*)xr)[lane + 64 * i]; h[rr][i] = v; ss += v.x * v.x + v.y * v.y + v.z * v.z + v.w * v.w; }
            }
            ss = wave_sum(ss);
            const float rs = rsqrtf(ss * (1.f / D) + 1e-6f);
#pragma unroll
            for (int i = 0; i < 4; ++i) {
                const float4 gg = ((const float4*)g)[lane + 64 * i], sh = ((const float4*)mv)[lane + 64 * i], sc = ((const float4*)(mv + 1024))[lane + 64 * i];
                float4 v = h[rr][i];
                v.x = v.x * rs * gg.x * (1.f + sc.x) + sh.x; v.y = v.y * rs * gg.y * (1.f + sc.y) + sh.y; v.z = v.z * rs * gg.z * (1.f + sc.z) + sh.z; v.w = v.w * rs * gg.w * (1.f + sc.w) + sh.w;
                h[rr][i] = v;
                uint2 o; o.x = pk2(v.x, v.y); o.y = pk2(v.z, v.w);
                if (which == 0) *(uint2*)(H + (size_t)(rbase + rr) * D + (lane + 64 * i) * 4) = o;
                if (which == 1 || !isctx || layer == 0) *(unsigned*)((unsigned char*)p->out + OUT_H8 + (size_t)(rbase + rr) * D + (lane + 64 * i) * 4) = f8x4(v.x, v.y, v.z, v.w);
            }
        }
        if (which == 1) {
            const LAS f32x4* wl = (const LAS f32x4*)smem;
            float gl[4][4];
#pragma unroll
            for (int o = 0; o < 4; ++o) {
                float a0 = 0.f, a1 = 0.f, a2 = 0.f, a3 = 0.f;
#pragma unroll
                for (int i = 0; i < 4; ++i) { const f32x4 wv = wl[o * 256 + lane + 64 * i]; const float4 w = {wv[0], wv[1], wv[2], wv[3]};
                    a0 += h[0][i].x * w.x + h[0][i].y * w.y + h[0][i].z * w.z + h[0][i].w * w.w; a1 += h[1][i].x * w.x + h[1][i].y * w.y + h[1][i].z * w.z + h[1][i].w * w.w;
                    a2 += h[2][i].x * w.x + h[2][i].y * w.y + h[2][i].z * w.z + h[2][i].w * w.w; a3 += h[3][i].x * w.x + h[3][i].y * w.y + h[3][i].z * w.z + h[3][i].w * w.w; }
                const float bg = p->in[34][layer * 4 + o];
                gl[0][o] = wave_sum(a0) + bg; gl[1][o] = wave_sum(a1) + bg; gl[2][o] = wave_sum(a2) + bg; gl[3][o] = wave_sum(a3) + bg;
            }
#pragma unroll
            for (int rr = 0; rr < 4; ++rr) {
                int gi = 0; float gm = gl[rr][0];
#pragma unroll
                for (int j = 1; j < 4; ++j) if (gl[rr][j] > gm) { gm = gl[rr][j]; gi = j; }
                float den = 0.f;
#pragma unroll
                for (int j = 0; j < 4; ++j) den += expf(gl[rr][j] - gm);
                const float gp = 1.f / den;
                gi = __builtin_amdgcn_readfirstlane(gi);
                float ev[8];
#pragma unroll
                for (int e = 0; e < 8; ++e) { float a = 0.f; const LAS f32x4* we = wl + (4 + gi * 8 + e) * 256;
#pragma unroll
                    for (int i = 0; i < 4; ++i) { const f32x4 wv = we[lane + 64 * i]; const float4 w = {wv[0], wv[1], wv[2], wv[3]}; a += h[rr][i].x * w.x + h[rr][i].y * w.y + h[rr][i].z * w.z + h[rr][i].w * w.w; }
                    ev[e] = a; }
#pragma unroll
                for (int e = 0; e < 8; ++e) ev[e] = wave_sum(ev[e]) + p->in[36][layer * 32 + gi * 8 + e];
                float v1 = -3.0e38f, v2 = -3.0e38f; int e1 = 0, e2 = 0;
#pragma unroll
                for (int e = 0; e < 8; ++e) { const float v = ev[e]; if (v > v1) { v2 = v1; e2 = e1; v1 = v; e1 = e; } else if (v > v2) { v2 = v; e2 = e; } }
                if (lane == 0 && live) {
                    const float p1 = 1.f / (1.f + expf(v2 - v1)), p2 = 1.f - p1;
                    int ea = e1, eb = e2; float wa = p1 * gp, wb = p2 * gp;
                    if (ea > eb) { const int t = ea; ea = eb; eb = t; const float tw = wa; wa = wb; wb = tw; }
                    const int cls = gi * 28 + (ea * (15 - ea)) / 2 + (eb - ea - 1), row = rbase + rr;
                    unsigned* cnt = (unsigned*)(p->ws + WS_CTL + CTL_CNT) + layer * 128 * 64;
                    const unsigned pos = atomicAdd(&cnt[cls * 64], 1u);
                    ((int*)(p->ws + WS_PROJ + PJ_PERM))[(size_t)cls * MOE_CAP + pos] = row;
                    ((float2*)(p->ws + WS_PROJ + PJ_TOKW))[row] = make_float2(wa, wb);
                }
            }
        }
    }
}

__device__ __forceinline__ bool xcd_unit_split(int bid, int nb, int i, int npanel, int ncol, int csplit, int& pm, int& pn) {
    const int xcd = bid & 7, rank = bid >> 3, nrank = nb >> 3;
    const int p0 = (npanel * xcd) >> 3, p1 = (npanel * (xcd + 1)) >> 3, np = p1 - p0, j = rank + i * nrank;
    if (j >= np * ncol) return false;
    if (j < np * csplit) { pm = p0 + j / csplit; pn = j % csplit; }
    else { const int j2 = j - np * csplit, c2 = ncol - csplit; pm = p0 + j2 / c2; pn = csplit + j2 % c2; }
    return true;
}
__device__ __forceinline__ bool xcd_unit(int bid, int nb, int i, int npanel, int ncol, int& pm, int& pn) {
    const int xcd = bid & 7, rank = bid >> 3, nrank = nb >> 3;
    const int p0 = (npanel * xcd) >> 3, p1 = (npanel * (xcd + 1)) >> 3, j = rank + i * nrank;
    if (j >= (p1 - p0) * ncol) return false;
    pm = p0 + j / ncol; pn = j % ncol; return true;
}
typedef const bf16_t* cbfp;
__device__ __forceinline__ void phase_inproj(KP p, int bid, int nb) {
    const char* H = (const char*)(p->ws + WS_HKV); const char* W = (const char*)((const bf16_t*)(p->ws + WS_WT) + WT_WIN); bf16_t* P = (bf16_t*)(p->ws + WS_PROJ);
    gemm256<true>(smem,
        [&](int i, U256& u) -> bool { int pm, pn; if (!xcd_unit_split(bid, nb, i, 132, 13, 7, pm, pn)) return false;
            u.A = H + (size_t)pm * 256 * D * 2; u.B = W + (size_t)pn * 256 * D * 2; u.K = D; return true; },
        [&](int i, f32x4 (&acc)[2][2][4][2], int wr, int wc, int fr, int fq) {
            int pm, pn; xcd_unit_split(bid, nb, i, 132, 13, 7, pm, pn);
            const int b = pm / 33, i0 = (pm % 33) * 256;
#pragma unroll
            for (int bj = 0; bj < 2; ++bj) { const int col = pn * 256 + bj * 128 + wc * 32 + fq * 8;
                if (col < NPROJ) {
                    size_t base; int rs_hi, rs_lo;
                    if (col < 256) { base = O_U + ((size_t)((b * 528 + (i0 >> 4)) * 16 + (col >> 4))) * 256 + (col & 15); rs_hi = 4096; rs_lo = 16; }
                    else if (col >= C_GA && col < C_NQ) { base = O_GA + (size_t)(b * RB + i0) * 32 + (col - C_GA); rs_hi = 512; rs_lo = 32; }
                    else if (col >= C_CV) { base = O_CV + (size_t)(b * RB + i0) * 512 + (col - C_CV); rs_hi = 8192; rs_lo = 512; }
                    else { size_t o; int cc, w;
                        if (col < C_GK) { o = O_GQ; cc = col - C_GQ; w = 64; } else if (col < C_GV) { o = O_GK; cc = col - C_GK; w = 64; }
                        else if (col < C_GR) { o = O_GV; cc = col - C_GV; w = 128; } else if (col < C_GA) { o = O_GR; cc = col - C_GR; w = 128; }
                        else if (col < C_NK) { o = O_NQ; cc = col - C_NQ; w = 64; } else if (col < C_NV) { o = O_NK; cc = col - C_NK; w = 64; } else { o = O_NV; cc = col - C_NV; w = 64; }
                        const int hh = cc / w, dd = cc % w;
                        base = o + ((size_t)(b * 4 + hh) * RB + i0) * w + dd; rs_hi = 16 * w; rs_lo = w; }
                    bf16_t* dst = P + base + (size_t)fr * rs_lo;
#pragma unroll
                    for (int ai = 0; ai < 2; ++ai)
#pragma unroll
                        for (int m = 0; m < 4; ++m) { uint4 o; o.x = pk2(acc[ai][bj][m][0][0], acc[ai][bj][m][0][1]); o.y = pk2(acc[ai][bj][m][0][2], acc[ai][bj][m][0][3]);
                            o.z = pk2(acc[ai][bj][m][1][0], acc[ai][bj][m][1][1]); o.w = pk2(acc[ai][bj][m][1][2], acc[ai][bj][m][1][3]);
                            *(uint4*)(dst + (size_t)(ai * 8 + wr * 4 + m) * rs_hi) = o; }
                } } });
}

__device__ __forceinline__ void phase_s5_gemm1(KP p, int layer, int bid, int nb) {
    typedef GT<128, 128, 2, 4> G;
    const int tid = tidx(), lane = tid & 63, wave = tid >> 6, wm = wave >> 2, wn = wave & 3, fr = lane & 15, fq = lane >> 4;
    const bf16_t* P = (const bf16_t*)(p->ws + WS_PROJ); bf16_t* Y = (bf16_t*)(p->ws + WS_YSUM); float* GU = (float*)(p->ws + WS_GU);
    gemm_stream<128, 128, 2, 4>(
        [&](int s, cbfp (&ap)[G::AI], long& kstep, cbfp (&bp)[G::BI], int& nk) -> bool {
            const int u = bid + s * nb; if (u >= 17 * 64) return false; const int mtile = u / 64, g = (u / 4) % 16, pn = u % 4;
            const bf16_t* W = (const bf16_t*)(p->ws + WS_S5W1) + ((size_t)layer * 16 + g) * 512 * 256;
#pragma unroll
            for (int i = 0; i < G::AI; ++i) { int ch = mtile * 128 + st_row(i); ch = ch < NCH16 ? ch : NCH16 - 1; const int c = st_chunk(i);
                ap[i] = P + O_U + ((size_t)ch * 16 + g) * 256 + c * 8; }
#pragma unroll
            for (int i = 0; i < G::BI; ++i) bp[i] = W + (size_t)(pn * 128 + st_row(i)) * 256 + st_chunk(i) * 8;
            kstep = 64; nk = 4; return true; },
        [&](int s, f32x4 (&acc)[G::MT][G::NTL]) {
            const int u = bid + s * nb, mtile = u / 64, g = (u / 4) % 16, pn = u % 4;
#pragma unroll
            for (int mt = 0; mt < G::MT; ++mt)
#pragma unroll
                for (int nt = 0; nt < G::NTL; ++nt) {
                    const int ch = mtile * 128 + wm * 64 + mt * 16 + fr, n = pn * 128 + wn * 32 + nt * 16 + fq * 4;
                    if (ch < NCH16) {
                        if (n < 256) { uint2 o; o.x = pk2(acc[mt][nt][0], acc[mt][nt][1]); o.y = pk2(acc[mt][nt][2], acc[mt][nt][3]);
                            *(uint2*)(Y + (size_t)(ch * 16 + (n >> 4)) * 256 + g * 16 + (n & 15)) = o; }
                        else *(f32x4*)(GU + ((size_t)ch * 16 + g) * 256 + (n - 256)) = acc[mt][nt];
                    }
                }
            ZERO_ACC(acc, G::MT, G::NTL); },
        smem);
}
__device__ __forceinline__ int s5_order(int d, int i) { return d == 0 ? i : (i < 16 ? 15 - i : 543 - i); }
__device__ __forceinline__ void unit_s5_scan(KP p, int layer, int u) {
    const int b = u >> 5, g = (u >> 1) & 15, d = u & 1, wave = tidx() >> 6, lane = tidx() & 63;
    const float2 A = ((const float2*)(p->ws + WS_A16))[(((size_t)layer * 2 + d) * 16 + g) * 64 + lane];
    const float* GU = (const float*)(p->ws + WS_GU); bf16_t* HIN = (bf16_t*)(p->ws + WS_HIN);
    float2* tot = (float2*)smem;
    __syncthreads();
    float hr = 0.f, hi = 0.f;
    for (int i0 = 0; i0 < 66; i0 += 22) {
        float gr[22], gim[22];
#pragma unroll
        for (int j = 0; j < 22; ++j) { const size_t ch = (size_t)b * 528 + s5_order(d, wave * 66 + i0 + j); gr[j] = GU[(ch * 16 + g) * 256 + d * 128 + lane]; gim[j] = GU[(ch * 16 + g) * 256 + d * 128 + 64 + lane]; }
#pragma unroll
        for (int j = 0; j < 22; ++j) { const float nr = A.x * hr - A.y * hi + gr[j], ni = A.x * hi + A.y * hr + gim[j]; hr = nr; hi = ni; }
    }
    tot[wave * 64 + lane] = make_float2(hr, hi);
    float a66r = 1.f, a66i = 0.f;
    for (int i = 0; i < 66; ++i) { const float nr = a66r * A.x - a66i * A.y, ni = a66r * A.y + a66i * A.x; a66r = nr; a66i = ni; }
    __syncthreads();
    hr = 0.f; hi = 0.f;
    for (int w = 0; w < wave; ++w) { const float2 t = tot[w * 64 + lane]; const float nr = a66r * hr - a66i * hi + t.x, ni = a66r * hi + a66i * hr + t.y; hr = nr; hi = ni; }
    for (int i0 = 0; i0 < 66; i0 += 22) {
        float gr[22], gim[22]; size_t chs[22];
#pragma unroll
        for (int j = 0; j < 22; ++j) { const size_t ch = (size_t)b * 528 + s5_order(d, wave * 66 + i0 + j); chs[j] = ch; gr[j] = GU[(ch * 16 + g) * 256 + d * 128 + lane]; gim[j] = GU[(ch * 16 + g) * 256 + d * 128 + 64 + lane]; }
#pragma unroll
        for (int j = 0; j < 22; ++j) {
            HIN[(chs[j] * 16 + g) * 256 + d * 128 + lane] = (bf16_t)f2bf(hr); HIN[(chs[j] * 16 + g) * 256 + d * 128 + 64 + lane] = (bf16_t)f2bf(hi);
            const float nr = A.x * hr - A.y * hi + gr[j], ni = A.x * hi + A.y * hr + gim[j]; hr = nr; hi = ni; }
    }
}
__device__ __forceinline__ void phase_s5_gemm2(KP p, int layer, int bid, int nb, bool live = true) {
    typedef GT<128, 128, 2, 4> G;
    const int tid = tidx(), lane = tid & 63, wave = tid >> 6, wm = wave >> 2, wn = wave & 3, fr = lane & 15, fq = lane >> 4;
    const bf16_t* HIN = (const bf16_t*)(p->ws + WS_HIN); bf16_t* Y = (bf16_t*)(p->ws + WS_YSUM);
    gemm_stream<128, 128, 2, 4>(
        [&](int s, cbfp (&ap)[G::AI], long& kstep, cbfp (&bp)[G::BI], int& nk) -> bool {
            const int u = bid + s * nb; if (u >= 17 * 32) return false; const int mtile = u / 32, g = (u / 2) % 16, pn = u % 2;
            const bf16_t* W = (const bf16_t*)(p->ws + WS_S5W2) + ((size_t)layer * 16 + g) * 256 * 256;
#pragma unroll
            for (int i = 0; i < G::AI; ++i) { int ch = mtile * 128 + st_row(i); ch = ch < NCH16 ? ch : NCH16 - 1; ap[i] = HIN + ((size_t)ch * 16 + g) * 256 + st_chunk(i) * 8; }
#pragma unroll
            for (int i = 0; i < G::BI; ++i) bp[i] = W + (size_t)(pn * 128 + st_row(i)) * 256 + st_chunk(i) * 8;
            kstep = 64; nk = 4; return true; },
        [&](int s, f32x4 (&acc)[G::MT][G::NTL]) {
            const int u = bid + s * nb, mtile = u / 32, g = (u / 2) % 16, pn = u % 2;
#pragma unroll
            for (int mt = 0; mt < G::MT; ++mt)
#pragma unroll
                for (int nt = 0; nt < G::NTL; ++nt) {
                    const int ch = mtile * 128 + wm * 64 + mt * 16 + fr, n = pn * 128 + wn * 32 + nt * 16 + fq * 4;
                    if (ch < NCH16) { uint2* q = (uint2*)(Y + (size_t)(ch * 16 + (n >> 4)) * 256 + g * 16 + (n & 15)); const uint2 y = *q;
                        uint2 o; o.x = pk2(gelu_t(acc[mt][nt][0] + bf2f(y.x & 0xFFFFu)), gelu_t(acc[mt][nt][1] + bf2f(y.x >> 16)));
                        o.y = pk2(gelu_t(acc[mt][nt][2] + bf2f(y.y & 0xFFFFu)), gelu_t(acc[mt][nt][3] + bf2f(y.y >> 16))); if (live) *q = o; }
                }
            ZERO_ACC(acc, G::MT, G::NTL); },
        smem);
}
__device__ __forceinline__ void phase_s5_glu(KP p, int layer, int bid, int nb) {
    typedef GT<256, 128, 4, 2> G;
    const int tid = tidx(), lane = tid & 63, wave = tid >> 6, wm = wave >> 1, wn = wave & 1, fr = lane & 15, fq = lane >> 4;
    const bf16_t* Zp = (const bf16_t*)(p->ws + WS_YSUM); const bf16_t* W = (const bf16_t*)(p->ws + WS_WT) + WT_WGLU;
    bf16_t* Z = (bf16_t*)(p->ws + WS_ZS5); const float* bg = p->in[20] + layer * 256;
    gemm_stream<256, 128, 4, 2>(
        [&](int s, cbfp (&ap)[G::AI], long& kstep, cbfp (&bp)[G::BI], int& nk) -> bool {
            const int u = bid + s * nb; if (u >= 132 * 2) return false; const int pm = u >> 1, pn = u & 1;
#pragma unroll
            for (int i = 0; i < G::AI; ++i) ap[i] = Zp + (size_t)(pm * 256 + st_row(i)) * 256 + st_chunk(i) * 8;
#pragma unroll
            for (int i = 0; i < G::BI; ++i) bp[i] = W + (size_t)(pn * 128 + st_row(i)) * 256 + st_chunk(i) * 8;
            kstep = 64; nk = 4; return true; },
        [&](int s, f32x4 (&acc)[G::MT][G::NTL]) {
            const int u = bid + s * nb, pm = u >> 1, pn = u & 1;
#pragma unroll
            for (int mt = 0; mt < G::MT; ++mt)
#pragma unroll
                for (int nt = 0; nt < G::NTL; ++nt) {
                    const int row = pm * 256 + wm * 64 + mt * 16 + fr, col = pn * 128 + wn * 64 + nt * 16 + fq * 4;
                    const uint2 z = *(const uint2*)(Zp + (size_t)row * 256 + col); const float4 bb = *(const float4*)(bg + col);
                    uint2 o; o.x = pk2(bf2f(z.x & 0xFFFFu) * sigm(acc[mt][nt][0] + bb.x), bf2f(z.x >> 16) * sigm(acc[mt][nt][1] + bb.y));
                    o.y = pk2(bf2f(z.y & 0xFFFFu) * sigm(acc[mt][nt][2] + bb.z), bf2f(z.y >> 16) * sigm(acc[mt][nt][3] + bb.w));
                    *(uint2*)(Z + (size_t)row * 256 + col) = o;
                }
            ZERO_ACC(acc, G::MT, G::NTL); },
        smem);
}

__device__ __forceinline__ void unit_conv(KP p, int layer, int u) {
    const int r0 = u * 64, tid = tidx(), i0 = r0 % RB;
    const int seq_lo = r0 - i0 + (i0 < CTX ? 0 : CTX), seq_hi = r0 - i0 + (i0 < CTX ? CTX : RB);
    bf16_t* gl = (bf16_t*)smem;
    float* co = (float*)(smem + 94 * 256 * 2);
    const bf16_t* P = (const bf16_t*)(p->ws + WS_PROJ);
    __syncthreads();
    {
        uint2 vv[12], gg[12];
#pragma unroll
        for (int k = 0; k < 12; ++k) { const int i = tid + k * NT, rr = i >> 6, c4 = (i & 63) * 4, row = r0 - 15 + rr; vv[k] = make_uint2(0u, 0u); gg[k] = make_uint2(0u, 0u);
            if (i < 94 * 64 && row >= seq_lo && row < seq_hi) { vv[k] = *(const uint2*)(P + O_CV + (size_t)row * 512 + c4); gg[k] = *(const uint2*)(P + O_CV + (size_t)row * 512 + 256 + c4); } }
#pragma unroll
        for (int k = 0; k < 12; ++k) { const int i = tid + k * NT, rr = i >> 6, c4 = (i & 63) * 4; const uint2 v = vv[k], gt = gg[k]; uint2 o;
            o.x = pk2(bf2f(v.x & 0xFFFFu) * sigm(bf2f(gt.x & 0xFFFFu)), bf2f(v.x >> 16) * sigm(bf2f(gt.x >> 16)));
            o.y = pk2(bf2f(v.y & 0xFFFFu) * sigm(bf2f(gt.y & 0xFFFFu)), bf2f(v.y >> 16) * sigm(bf2f(gt.y >> 16)));
            if (i < 94 * 64) *(uint2*)(gl + rr * 256 + c4) = o; }
    }
    const int cp = tid & 127, rg = tid >> 7;
    float2 w[31];
#pragma unroll
    for (int j = 0; j < 31; ++j) w[j] = *(const float2*)(p->in[28] + ((size_t)layer * 31 + j) * 256 + 2 * cp);
    const float2 bias = *(const float2*)(p->in[29] + layer * 256 + 2 * cp);
    __syncthreads();
    {
        float x0[46], x1[46];
#pragma unroll
        for (int i = 0; i < 46; ++i) { const unsigned v = *(const unsigned*)(gl + (rg * 16 + i) * 256 + 2 * cp); x0[i] = __uint_as_float(v << 16); x1[i] = __uint_as_float(v & 0xFFFF0000u); }
#pragma unroll
        for (int t = 0; t < 16; ++t) { float s0 = bias.x, s1 = bias.y;
#pragma unroll
            for (int j = 0; j < 31; ++j) { s0 = __builtin_fmaf(w[j].x, x0[t + j], s0); s1 = __builtin_fmaf(w[j].y, x1[t + j], s1); }
            *(float2*)(co + (rg * 16 + t) * 256 + 2 * cp) = make_float2(s0, s1); }
    }
    __syncthreads();
    const int wave = tid >> 6, lane = tid & 63;
    const float4 lg = *(const float4*)(p->in[30] + layer * 256 + lane * 4), lb = *(const float4*)(p->in[31] + layer * 256 + lane * 4);
    bf16_t* Z = (bf16_t*)(p->ws + WS_ZCV);
    for (int t = wave * 8; t < wave * 8 + 8; ++t) {
        const float4 v = *(const float4*)(co + t * 256 + lane * 4);
        const float mean = wave_sum(v.x + v.y + v.z + v.w) * (1.f / 256.f);
        const float dx = v.x - mean, dy = v.y - mean, dz = v.z - mean, dw = v.w - mean;
        const float rs = rsqrtf(wave_sum(dx * dx + dy * dy + dz * dz + dw * dw) * (1.f / 256.f) + 1e-6f);
        float a = dx * rs * lg.x + lb.x, b = dy * rs * lg.y + lb.y, cc = dz * rs * lg.z + lb.z, d = dw * rs * lg.w + lb.w;
        a *= sigm(a); b *= sigm(b); cc *= sigm(cc); d *= sigm(d);
        uint2 o; o.x = pk2(a, b); o.y = pk2(cc, d);
        *(uint2*)(Z + (size_t)(r0 + t) * 256 + lane * 4) = o;
    }
}

constexpr int NA_LQ = 144, NA_LP = 272;
typedef short s16x4 __attribute__((ext_vector_type(4)));
__device__ __forceinline__ bf16x8 na_pfrag(const f32x4& a, const f32x4& b) { const uint4 w = make_uint4(pk2(a[0], a[1]), pk2(a[2], a[3]), pk2(b[0], b[1]), pk2(b[2], b[3])); return __builtin_bit_cast(bf16x8, w); }
__device__ __forceinline__ void unit_na(KP p, int layer, int u) {
    const int tid = tidx(), lane = tid & 63, wave = tid >> 6, fr = lane & 15, fq = lane >> 4, mtw = wave & 3, kh = wave >> 2;
    int b, h, r = 0, qrow0, t_lo; bool lat = u < 2048;
    if (lat) { b = u >> 9; h = (u >> 7) & 3; r = u & 127; qrow0 = b * RB + CTX + r * 64; t_lo = 0; }
    else { const int v = u - 2048; b = v >> 4; h = (v >> 2) & 3; qrow0 = b * RB + (v & 3) * 64; t_lo = 2; }
    const int hrow0 = (b * 4 + h) * RB;
    const int row_start = r - 4 < 0 ? 0 : (r - 4 > 120 ? 120 : r - 4);
    unsigned char* Ql = smem;
    unsigned char* Kl = Ql + 64 * NA_LQ;
    unsigned char* Vl = Kl + 256 * NA_LQ;
    unsigned char* Pl = Vl + 256 * NA_LQ;
    float* rpb = (float*)(Pl + 8 * 16 * NA_LP);
    float* mrg = rpb + 480;
    const bf16_t* P = (const bf16_t*)(p->ws + WS_PROJ);
    __syncthreads();
    { const int q = tid >> 3, c = tid & 7; const uint4 v = *(const uint4*)(P + O_NQ + (size_t)(hrow0 + (qrow0 - b * RB) + q) * 64 + c * 8); uint4 w;
      w.x = pk2(bf2f(v.x & 0xFFFFu) * 0.125f, bf2f(v.x >> 16) * 0.125f); w.y = pk2(bf2f(v.y & 0xFFFFu) * 0.125f, bf2f(v.y >> 16) * 0.125f);
      w.z = pk2(bf2f(v.z & 0xFFFFu) * 0.125f, bf2f(v.z >> 16) * 0.125f); w.w = pk2(bf2f(v.w & 0xFFFFu) * 0.125f, bf2f(v.w >> 16) * 0.125f);
      *(uint4*)(Ql + q * NA_LQ + c * 16) = w; }
    for (int i = tid; i < 465; i += NT) rpb[i] = p->in[26][((size_t)layer * 4 + h) * 465 + i];
    float m_run = -1e30f, l_run = 0.f; f32x4 o[4];
    const int cb = mtw == 0 ? 0 : (mtw == 3 ? 32 : 16 * mtw - 8);
    int dcm[2][4];
#pragma unroll
    for (int nt = 0; nt < 4; ++nt) o[nt] = (f32x4){0.f, 0.f, 0.f, 0.f};
#pragma unroll
    for (int n = 0; n < 2; ++n)
#pragma unroll
        for (int j = 0; j < 4; ++j) { const int cq = mtw * 16 + fr, ck = cb + n * 16 + 4 * fq + j; int cs = cq - 8; cs = cs < 0 ? 0 : (cs > 48 ? 48 : cs);
            int dc = ck - cq + 15; dc = dc < 0 ? 0 : (dc > 30 ? 30 : dc); dcm[n][j] = (ck >= cs && ck < cs + 16) ? dc : -1; }
    uint4 kg00 = make_uint4(0u, 0u, 0u, 0u), vg00 = make_uint4(0u, 0u, 0u, 0u), kg01 = make_uint4(0u, 0u, 0u, 0u), vg01 = make_uint4(0u, 0u, 0u, 0u), kg02 = make_uint4(0u, 0u, 0u, 0u), vg02 = make_uint4(0u, 0u, 0u, 0u), kg03 = make_uint4(0u, 0u, 0u, 0u), vg03 = make_uint4(0u, 0u, 0u, 0u), kg10 = make_uint4(0u, 0u, 0u, 0u), vg10 = make_uint4(0u, 0u, 0u, 0u), kg11 = make_uint4(0u, 0u, 0u, 0u), vg11 = make_uint4(0u, 0u, 0u, 0u), kg12 = make_uint4(0u, 0u, 0u, 0u), vg12 = make_uint4(0u, 0u, 0u, 0u), kg13 = make_uint4(0u, 0u, 0u, 0u), vg13 = make_uint4(0u, 0u, 0u, 0u), kg20 = make_uint4(0u, 0u, 0u, 0u), vg20 = make_uint4(0u, 0u, 0u, 0u), kg21 = make_uint4(0u, 0u, 0u, 0u), vg21 = make_uint4(0u, 0u, 0u, 0u), kg22 = make_uint4(0u, 0u, 0u, 0u), vg22 = make_uint4(0u, 0u, 0u, 0u), kg23 = make_uint4(0u, 0u, 0u, 0u), vg23 = make_uint4(0u, 0u, 0u, 0u);
    const int ko0 = (hrow0 + CTX + row_start * 64 + (tid >> 3)) * 64 + (tid & 7) * 8;
    const int ctx_delta = -(CTX + row_start * 64) * 64;
    if (0 >= t_lo) { kg00 = *(const uint4*)(P + O_NK + (size_t)(unsigned)(ko0 + 0 * 256 * 64 + 0 * 64 * 64)); vg00 = *(const uint4*)(P + O_NV + (size_t)(unsigned)(ko0 + 0 * 256 * 64 + 0 * 64 * 64)); kg01 = *(const uint4*)(P + O_NK + (size_t)(unsigned)(ko0 + 0 * 256 * 64 + 1 * 64 * 64)); vg01 = *(const uint4*)(P + O_NV + (size_t)(unsigned)(ko0 + 0 * 256 * 64 + 1 * 64 * 64)); kg02 = *(const uint4*)(P + O_NK + (size_t)(unsigned)(ko0 + 0 * 256 * 64 + 2 * 64 * 64)); vg02 = *(const uint4*)(P + O_NV + (size_t)(unsigned)(ko0 + 0 * 256 * 64 + 2 * 64 * 64)); kg03 = *(const uint4*)(P + O_NK + (size_t)(unsigned)(ko0 + 0 * 256 * 64 + 3 * 64 * 64)); vg03 = *(const uint4*)(P + O_NV + (size_t)(unsigned)(ko0 + 0 * 256 * 64 + 3 * 64 * 64)); }
    if (1 >= t_lo) { kg10 = *(const uint4*)(P + O_NK + (size_t)(unsigned)(ko0 + 1 * 256 * 64 + 0 * 64 * 64)); vg10 = *(const uint4*)(P + O_NV + (size_t)(unsigned)(ko0 + 1 * 256 * 64 + 0 * 64 * 64)); kg11 = *(const uint4*)(P + O_NK + (size_t)(unsigned)(ko0 + 1 * 256 * 64 + 1 * 64 * 64)); vg11 = *(const uint4*)(P + O_NV + (size_t)(unsigned)(ko0 + 1 * 256 * 64 + 1 * 64 * 64)); kg12 = *(const uint4*)(P + O_NK + (size_t)(unsigned)(ko0 + 1 * 256 * 64 + 2 * 64 * 64)); vg12 = *(const uint4*)(P + O_NV + (size_t)(unsigned)(ko0 + 1 * 256 * 64 + 2 * 64 * 64)); kg13 = *(const uint4*)(P + O_NK + (size_t)(unsigned)(ko0 + 1 * 256 * 64 + 3 * 64 * 64)); vg13 = *(const uint4*)(P + O_NV + (size_t)(unsigned)(ko0 + 1 * 256 * 64 + 3 * 64 * 64)); }
    if (2 >= t_lo) { kg20 = *(const uint4*)(P + O_NK + (size_t)(unsigned)(ko0 + ctx_delta + 0 * 64 * 64)); vg20 = *(const uint4*)(P + O_NV + (size_t)(unsigned)(ko0 + ctx_delta + 0 * 64 * 64)); kg21 = *(const uint4*)(P + O_NK + (size_t)(unsigned)(ko0 + ctx_delta + 1 * 64 * 64)); vg21 = *(const uint4*)(P + O_NV + (size_t)(unsigned)(ko0 + ctx_delta + 1 * 64 * 64)); kg22 = *(const uint4*)(P + O_NK + (size_t)(unsigned)(ko0 + ctx_delta + 2 * 64 * 64)); vg22 = *(const uint4*)(P + O_NV + (size_t)(unsigned)(ko0 + ctx_delta + 2 * 64 * 64)); kg23 = *(const uint4*)(P + O_NK + (size_t)(unsigned)(ko0 + ctx_delta + 3 * 64 * 64)); vg23 = *(const uint4*)(P + O_NV + (size_t)(unsigned)(ko0 + ctx_delta + 3 * 64 * 64)); }
#define NA_PUT(K_, V_, e_) do { *(uint4*)(Kl + ((tid >> 3) + (e_) * 64) * NA_LQ + (tid & 7) * 16) = (K_); *(uint4*)(Vl + ((tid >> 3) + (e_) * 64) * NA_LQ + (tid & 7) * 16) = (V_); } while (0)
#pragma unroll
    for (int t = 0; t < 3; ++t) if (t >= t_lo) {
        __syncthreads();
        if (t == 0) { NA_PUT(kg00, vg00, 0); NA_PUT(kg01, vg01, 1); NA_PUT(kg02, vg02, 2); NA_PUT(kg03, vg03, 3); }
        else if (t == 1) { NA_PUT(kg10, vg10, 0); NA_PUT(kg11, vg11, 1); NA_PUT(kg12, vg12, 2); NA_PUT(kg13, vg13, 3); }
        else { NA_PUT(kg20, vg20, 0); NA_PUT(kg21, vg21, 1); NA_PUT(kg22, vg22, 2); NA_PUT(kg23, vg23, 3); }
        __syncthreads();
        if (t < 2) {
            f32x4 s0[2] = {}, s1[2] = {};
            wave_mma_t<2, 2>(s0, Ql + mtw * 16 * NA_LQ, NA_LQ, Kl + (kh * 128 + cb) * NA_LQ, NA_LQ);
            wave_mma_t<2, 2>(s1, Ql + mtw * 16 * NA_LQ, NA_LQ, Kl + (kh * 128 + 64 + cb) * NA_LQ, NA_LQ);
            const float* rb = rpb + (row_start + 4 * t + 2 * kh - r + 7) * 31;
#pragma unroll
            for (int n = 0; n < 2; ++n)
#pragma unroll
                for (int j = 0; j < 4; ++j) { s0[n][j] = dcm[n][j] >= 0 ? s0[n][j] + rb[dcm[n][j]] : -1e30f; s1[n][j] = dcm[n][j] >= 0 ? s1[n][j] + rb[31 + dcm[n][j]] : -1e30f; }
            float mx = -1e30f;
#pragma unroll
            for (int n = 0; n < 2; ++n) mx = fmaxf(mx, fmaxf(fmaxf(fmaxf(s0[n][0], s0[n][1]), fmaxf(s0[n][2], s0[n][3])), fmaxf(fmaxf(s1[n][0], s1[n][1]), fmaxf(s1[n][2], s1[n][3]))));
            mx = fmaxf(mx, __shfl_xor(mx, 16)); mx = fmaxf(mx, __shfl_xor(mx, 32));
            const float mn = fmaxf(m_run, mx), al = __expf(m_run - mn); m_run = mn;
            float rs = 0.f;
#pragma unroll
            for (int n = 0; n < 2; ++n)
#pragma unroll
                for (int j = 0; j < 4; ++j) { const float e0 = __expf(s0[n][j] - mn), e1 = __expf(s1[n][j] - mn); s0[n][j] = e0; s1[n][j] = e1; rs += e0 + e1; }
            rs += __shfl_xor(rs, 16); rs += __shfl_xor(rs, 32);
            l_run = l_run * al + rs;
#pragma unroll
            for (int nt = 0; nt < 4; ++nt) o[nt] *= al;
            const bf16x8 pfa = na_pfrag(s0[0], s0[1]), pfb = na_pfrag(s1[0], s1[1]);
            const unsigned char* vb = Vl + (kh * 128 + cb + 4 * fq + (fr >> 2)) * NA_LQ + (fr & 3) * 8;
#pragma unroll
            for (int ks = 0; ks < 2; ++ks) { const bf16x8 pf = ks ? pfb : pfa;
#pragma unroll
                for (int nt = 0; nt < 4; ++nt) {
                    const s16x4 v0 = __builtin_amdgcn_ds_read_tr16_b64_v4i16((LAS s16x4*)(vb + ks * 64 * NA_LQ + nt * 32)), v1 = __builtin_amdgcn_ds_read_tr16_b64_v4i16((LAS s16x4*)(vb + (ks * 64 + 16) * NA_LQ + nt * 32));
                    const bf16x8 vf = {v0[0], v0[1], v0[2], v0[3], v1[0], v1[1], v1[2], v1[3]};
                    o[nt] = __builtin_amdgcn_mfma_f32_16x16x32_bf16(vf, pf, o[nt], 0, 0, 0); } }
        } else {
        f32x4 s[8] = {};
        wave_mma_t<8, 2>(s, Ql + mtw * 16 * NA_LQ, NA_LQ, Kl + kh * 128 * NA_LQ, NA_LQ);
        float mx = -1e30f;
#pragma unroll
        for (int nt = 0; nt < 8; ++nt) mx = fmaxf(mx, fmaxf(fmaxf(s[nt][0], s[nt][1]), fmaxf(s[nt][2], s[nt][3])));
        mx = fmaxf(mx, __shfl_xor(mx, 16)); mx = fmaxf(mx, __shfl_xor(mx, 32));
        const float mn = fmaxf(m_run, mx), al = __expf(m_run - mn); m_run = mn;
        float rs = 0.f;
#pragma unroll
        for (int nt = 0; nt < 8; ++nt)
#pragma unroll
            for (int j = 0; j < 4; ++j) { const float e = __expf(s[nt][j] - mn); s[nt][j] = e; rs += e; }
        rs += __shfl_xor(rs, 16); rs += __shfl_xor(rs, 32);
        l_run = l_run * al + rs;
#pragma unroll
        for (int nt = 0; nt < 4; ++nt) o[nt] *= al;
        {
            const unsigned char* vb = Vl + (kh * 128 + 4 * fq + (fr >> 2)) * NA_LQ + (fr & 3) * 8;
#pragma unroll
            for (int ks = 0; ks < 4; ++ks) { const bf16x8 pf = na_pfrag(s[2 * ks], s[2 * ks + 1]);
#pragma unroll
                for (int nt = 0; nt < 4; ++nt) {
                    const s16x4 v0 = __builtin_amdgcn_ds_read_tr16_b64_v4i16((LAS s16x4*)(vb + ks * 32 * NA_LQ + nt * 32)), v1 = __builtin_amdgcn_ds_read_tr16_b64_v4i16((LAS s16x4*)(vb + (ks * 32 + 16) * NA_LQ + nt * 32));
                    const bf16x8 vf = {v0[0], v0[1], v0[2], v0[3], v1[0], v1[1], v1[2], v1[3]};
                    o[nt] = __builtin_amdgcn_mfma_f32_16x16x32_bf16(vf, pf, o[nt], 0, 0, 0); } } }
        }
    }
    if (kh == 1) { float* q = mrg + (mtw * 64 + lane) * 24; q[0] = m_run; q[1] = l_run;
#pragma unroll
        for (int nt = 0; nt < 4; ++nt) *(f32x4*)(q + 8 + nt * 4) = o[nt]; }
    __syncthreads();
    if (kh == 0) { const float* q = mrg + (mtw * 64 + lane) * 24; bf16_t* Z = (bf16_t*)(p->ws + WS_ZNA);
        const float m2 = q[0], l2 = q[1], mn = fmaxf(m_run, m2), a1 = __expf(m_run - mn), a2 = __expf(m2 - mn), inv = __builtin_amdgcn_rcpf(l_run * a1 + l2 * a2);
#pragma unroll
        for (int nt = 0; nt < 4; ++nt) { const f32x4 o2 = *(const f32x4*)(q + 8 + nt * 4); const f32x4 v = (o[nt] * a1 + o2 * a2) * inv;
            uint2 w; w.x = pk2(v[0], v[1]); w.y = pk2(v[2], v[3]); *(uint2*)(Z + (size_t)(qrow0 + mtw * 16 + fr) * 256 + h * 64 + nt * 16 + 4 * fq) = w; }
    }
}

constexpr int GL_L64 = 144;
constexpr int GL_LV = 272;
__device__ __forceinline__ bf16x8 tr_frag(const unsigned char* img, int ld, int k0, int c0) {
    const int lane = tidx() & 63, fr = lane & 15, fq = lane >> 4;
    const unsigned char* a = img + (k0 + 8 * fq + (fr >> 2)) * ld + (c0 + (fr & 3) * 4) * 2;
    const s16x4 v0 = __builtin_amdgcn_ds_read_tr16_b64_v4i16((LAS s16x4*)a), v1 = __builtin_amdgcn_ds_read_tr16_b64_v4i16((LAS s16x4*)(a + 4 * ld));
    return (bf16x8){v0[0], v0[1], v0[2], v0[3], v1[0], v1[1], v1[2], v1[3]};
}
__device__ __forceinline__ bf16x8 tr_frag_p(const unsigned char* img, int ld, int k0, int c0) {
    const int lane = tidx() & 63, fr = lane & 15, fq = lane >> 4;
    const unsigned char* a = img + (k0 + 4 * fq + (fr >> 2)) * ld + (c0 + (fr & 3) * 4) * 2;
    const s16x4 v0 = __builtin_amdgcn_ds_read_tr16_b64_v4i16((LAS s16x4*)a), v1 = __builtin_amdgcn_ds_read_tr16_b64_v4i16((LAS s16x4*)(a + 16 * ld));
    return (bf16x8){v0[0], v0[1], v0[2], v0[3], v1[0], v1[1], v1[2], v1[3]};
}
__device__ __forceinline__ void gla_rope_tile(KP p, const bf16_t* src0, bool lat, int grow, float scale, float* dst) {
    const int tid = tidx(), t = tid >> 3, c = tid & 7, half = c >> 2, cc = c & 3;
    const bf16_t* src = src0 + (size_t)t * 64;
    const uint4 v = *(const uint4*)(src + c * 8); const unsigned* w = (const unsigned*)&v; float x[8];
#pragma unroll
    for (int j = 0; j < 4; ++j) { x[2 * j] = bf2f(w[j] & 0xFFFFu); x[2 * j + 1] = bf2f(w[j] >> 16); }
    if (lat) {
        const uint4 pv = *(const uint4*)(src + (c ^ 2) * 8); const unsigned* pw = (const unsigned*)&pv;
        const float* tb = (const float*)(p->ws + WS_ROPE) + (half ? 4096 + t * 16 : grow * 16) + (cc & 1) * 8;
        const float* ts = tb + (half ? 1024 : 2048);
        const float sg = (cc & 2) ? 1.f : -1.f;
#pragma unroll
        for (int j = 0; j < 8; ++j) { const float y = bf2f((j & 1) ? (pw[j >> 1] >> 16) : (pw[j >> 1] & 0xFFFFu)); x[j] = x[j] * tb[j] + sg * y * ts[j]; }
    }
#pragma unroll
    for (int j = 0; j < 8; ++j) dst[t * 65 + c * 8 + j] = x[j] * scale;
}
__device__ __forceinline__ void unit_gla_g1(KP p, int layer, int u) {
    const int bc = u >> 2, h = u & 3, b = bc / 132, c = bc % 132, row0 = b * RB + c * 64, tid = tidx(), lane = tid & 63, wave = tid >> 6, fr = lane & 15, fq = lane >> 4;
    const bool lat = c >= 4;
    float* bl = (float*)smem;
    float* kf = bl + 64 * 129;
    unsigned char* vR = (unsigned char*)(kf + 64 * 65);
    unsigned char* kE = vR + 64 * GL_LV;
    unsigned char* aL = kE + 64 * GL_L64;
    unsigned char* wB = aL + 64 * 80;
    const bf16_t* P = (const bf16_t*)(p->ws + WS_PROJ);
    __syncthreads();
    gla_rope_tile(p, P + O_GK + (size_t)((b * 4 + h) * RB + c * 64) * 64, lat, c - 4, 1.f, kf);
#pragma unroll
    for (int e = 0; e < 2; ++e) { const int i = tid + e * NT, j = i >> 4, cc = i & 15; *(uint4*)(vR + j * GL_LV + cc * 16) = *(const uint4*)(P + O_GV + (size_t)((b * 4 + h) * RB + c * 64 + j) * 128 + cc * 8); }
    if (tid < 256) { const int t = tid >> 2, c4 = tid & 3; *(uint4*)(aL + t * 80 + c4 * 16) = *(const uint4*)(P + O_GA + (size_t)(row0 + t) * 32 + c4 * 8); }
    for (int i = tid; i < 640; i += NT) *(uint4*)(wB + i * 16) = *(const uint4*)(p->ws + WS_GWB + ((size_t)layer * 4 + h) * 10240 + i * 16);
    __syncthreads();
    { f32x4 z[4] = {};
      wave_mma<4, 1>(z, aL + (wave & 3) * 16 * 80, 80, wB + (wave >> 2) * 64 * 80, 80);
#pragma unroll
      for (int nt = 0; nt < 4; ++nt) { const int col = (wave >> 2) * 64 + nt * 16 + fr; const float bias = p->in[23][((size_t)layer * 2 + (col >> 6)) * 256 + h * 64 + (col & 63)];
#pragma unroll
          for (int j = 0; j < 4; ++j) { const float zz = z[nt][j] + bias; bl[((wave & 3) * 16 + 4 * fq + j) * 129 + col] = (fminf(zz, 0.f) - __logf(1.f + __expf(-fabsf(zz)))) * (1.f / 16.f); } } }
    __syncthreads();
    for (int cc = 0; cc < 16; ++cc) {
        const int col = wave * 16 + cc; float v = bl[lane * 129 + col];
        v = col < 64 ? wave_prefix_sum(v) : wave_suffix_sum(v);
        bl[lane * 129 + col] = v;
    }
    __syncthreads();
    { unsigned short* BC = (unsigned short*)(p->ws + WS_BC);
      for (int i = tid; i < 64 * 16; i += NT) { const int t = i >> 4, c8 = i & 15, d = c8 >> 3; unsigned w[4];
#pragma unroll
          for (int j = 0; j < 4; ++j) { const float b0 = fminf(-bl[t * 129 + c8 * 8 + 2 * j] * 4096.f, 65535.f), b1 = fminf(-bl[t * 129 + c8 * 8 + 2 * j + 1] * 4096.f, 65535.f);
              w[j] = (unsigned)(b0 + 0.5f) | ((unsigned)(b1 + 0.5f) << 16); }
          *(uint4*)(BC + (((size_t)(row0 + t) * 4 + h) * 2 + d) * 64 + (c8 & 7) * 8) = make_uint4(w[0], w[1], w[2], w[3]); } }
    for (int d = 0; d < 2; ++d) {
        const int last = d == 0 ? 63 : 0;
        { const int j = tid >> 3, c8 = (tid & 7) * 8; float e8[8];
#pragma unroll
          for (int q = 0; q < 8; ++q) e8[q] = kf[j * 65 + c8 + q] * __expf(bl[last * 129 + d * 64 + c8 + q] - bl[j * 129 + d * 64 + c8 + q]);
          *(uint4*)(kE + j * GL_L64 + c8 * 2) = make_uint4(pk2(e8[0], e8[1]), pk2(e8[2], e8[3]), pk2(e8[4], e8[5]), pk2(e8[6], e8[7])); }
        const size_t unit = ((size_t)bc * 4 + h) * 2 + d;
        if (tid < 64) ((float*)(p->ws + WS_DECAY))[unit * 64 + tid] = __expf(bl[last * 129 + d * 64 + tid]);
        __syncthreads();
        f32x4 acc[4] = {};
        {
#pragma unroll
            for (int ks = 0; ks < 2; ++ks) { const bf16x8 ef = tr_frag(vR, GL_LV, ks * 32, wave * 16);
#pragma unroll
                for (int nt = 0; nt < 4; ++nt) { const bf16x8 kf8 = tr_frag(kE, GL_L64, ks * 32, nt * 16);
                    acc[nt] = __builtin_amdgcn_mfma_f32_16x16x32_bf16(kf8, ef, acc[nt], 0, 0, 0); } } }
        bf16_t* KV = (bf16_t*)kv_base(p, layer) + unit * 8192;
#pragma unroll
        for (int nt = 0; nt < 4; ++nt) { uint2 o; o.x = pk2(acc[nt][0], acc[nt][1]); o.y = pk2(acc[nt][2], acc[nt][3]); *(uint2*)(KV + (wave * 16 + fr) * 64 + nt * 16 + 4 * fq) = o; }
        __syncthreads();
    }
}
__device__ __forceinline__ int gla_order(int d, int i) { return d == 0 ? i : (i < 4 ? 3 - i : 135 - i); }
__device__ __forceinline__ void unit_gla_g2(KP p, int layer, int u, bool live = true) {
    const int bhd = u >> 3, sl = u & 7, b = bhd >> 3, h = (bhd >> 1) & 3, d = bhd & 1, tid = tidx();
    const int e2 = sl * 512 + tid;
    const int dk = (e2 * 2) & 63;
    unsigned* KV = (unsigned*)kv_base(p, layer); const float* DEC = (const float*)(p->ws + WS_DECAY);
    float s0 = 0.f, s1 = 0.f;
    for (int i0 = 0; i0 < 132; i0 += 22) {
        unsigned kv[22]; float2 dc[22]; size_t un[22];
#pragma unroll
        for (int j = 0; j < 22; ++j) { un[j] = (((size_t)b * 132 + gla_order(d, i0 + j)) * 4 + h) * 2 + d; kv[j] = KV[un[j] * 4096 + e2]; dc[j] = *(const float2*)(DEC + un[j] * 64 + dk); }
#pragma unroll
        for (int j = 0; j < 22; ++j) { if (live) KV[un[j] * 4096 + e2] = pk2(s0, s1); s0 = dc[j].x * s0 + bf2f(kv[j] & 0xFFFFu); s1 = dc[j].y * s1 + bf2f(kv[j] >> 16); }
    }
}
__device__ __forceinline__ void unit_gla_g3(KP p, int layer, int u) {
    const int bc = u >> 2, h = u & 3, b = bc / 132, c = bc % 132, row0 = b * RB + c * 64, tid = tidx(), lane = tid & 63, wave = tid >> 6, fr = lane & 15, fq = lane >> 4;
    const bool lat = c >= 4;
    float* bl = (float*)smem;
    float* qf = bl + 64 * 65;
    float* kf = qf + 64 * 65;
    unsigned char* qt = (unsigned char*)(kf + 64 * 65);
    unsigned char* kt = qt + 64 * GL_L64;
    unsigned char* vR = kt + 64 * GL_L64;
    unsigned char* at = vR + 64 * GL_LV;
    unsigned char* sT = at + 64 * GL_L64;
    float* of = bl;
    const bf16_t* P = (const bf16_t*)(p->ws + WS_PROJ);
    __syncthreads();
    gla_rope_tile(p, P + O_GK + (size_t)((b * 4 + h) * RB + c * 64) * 64, lat, c - 4, 1.f, kf);
    gla_rope_tile(p, P + O_GQ + (size_t)((b * 4 + h) * RB + c * 64) * 64, lat, c - 4, 0.125f, qf);
#pragma unroll
    for (int e = 0; e < 2; ++e) { const int i = tid + e * NT, j = i >> 4, cc = i & 15; *(uint4*)(vR + j * GL_LV + cc * 16) = *(const uint4*)(P + O_GV + (size_t)((b * 4 + h) * RB + c * 64 + j) * 128 + cc * 8); }
    const int mtw = wave & 3, nh = wave >> 2;
    f32x4 o[4] = {};
    const unsigned short* BCp = (const unsigned short*)(p->ws + WS_BC) + (((size_t)(row0 + (tid >> 3)) * 4 + h) * 2) * 64 + (tid & 7) * 8;
    const uint4 bcv0 = *(const uint4*)(BCp), bcv1 = *(const uint4*)(BCp + 64);
    const bf16_t* KVp = (const bf16_t*)kv_base(p, layer) + (((size_t)bc * 4 + h) * 2) * 8192 + (tid >> 3) * 64 + (tid & 7) * 8;
    const uint4 st00 = *(const uint4*)(KVp), st01 = *(const uint4*)(KVp + 4096), st10 = *(const uint4*)(KVp + 8192), st11 = *(const uint4*)(KVp + 8192 + 4096);
    for (int d = 0; d < 2; ++d) {
        { const int t = tid >> 3, c8 = tid & 7; const uint4 v = d ? bcv1 : bcv0; float* q = bl + t * 65 + c8 * 8;
          q[0] = -(float)(v.x & 0xFFFFu) * (1.f / 4096.f); q[1] = -(float)(v.x >> 16) * (1.f / 4096.f); q[2] = -(float)(v.y & 0xFFFFu) * (1.f / 4096.f); q[3] = -(float)(v.y >> 16) * (1.f / 4096.f);
          q[4] = -(float)(v.z & 0xFFFFu) * (1.f / 4096.f); q[5] = -(float)(v.z >> 16) * (1.f / 4096.f); q[6] = -(float)(v.w & 0xFFFFu) * (1.f / 4096.f); q[7] = -(float)(v.w >> 16) * (1.f / 4096.f); }
        __syncthreads();
        for (int i = tid; i < 64 * 64; i += NT) { const int dk = i & 63, t = i >> 6; const float bb = bl[t * 65 + dk];
            *(bf16_t*)(qt + t * GL_L64 + dk * 2) = (bf16_t)f2bf(qf[t * 65 + dk] * __expf(bb)); *(bf16_t*)(kt + t * GL_L64 + dk * 2) = (bf16_t)f2bf(kf[t * 65 + dk] * __expf(-bb)); }
        *(uint4*)(sT + (tid >> 3) * GL_L64 + (tid & 7) * 16) = d ? st10 : st00; *(uint4*)(sT + (64 + (tid >> 3)) * GL_L64 + (tid & 7) * 16) = d ? st11 : st01;
        __syncthreads();
        {
            f32x4 a[4] = {};
            wave_mma_t<4, 2>(a, qt + mtw * 16 * GL_L64, GL_L64, kt, GL_L64);
            const int ii = mtw * 16 + fr;
#pragma unroll
            for (int nt = 0; nt < 4; ++nt)
#pragma unroll
                for (int j = 0; j < 4; ++j) { const int jj = nt * 16 + 4 * fq + j; a[nt][j] = (d == 0 ? (jj <= ii) : (jj >= ii)) ? a[nt][j] : 0.f; }
#pragma unroll
            for (int ks = 0; ks < 2; ++ks) { const bf16x8 af = na_pfrag(a[2 * ks], a[2 * ks + 1]);
#pragma unroll
                for (int nt = 0; nt < 4; ++nt) o[nt] = __builtin_amdgcn_mfma_f32_16x16x32_bf16(tr_frag_p(vR, GL_LV, ks * 32, nh * 64 + nt * 16), af, o[nt], 0, 0, 0); } }
        wave_mma_t<4, 2>(o, qt + mtw * 16 * GL_L64, GL_L64, sT + nh * 64 * GL_L64, GL_L64);
        __syncthreads();
    }
    float ss = 0.f;
#pragma unroll
    for (int nt = 0; nt < 4; ++nt)
#pragma unroll
        for (int j = 0; j < 4; ++j) ss += o[nt][j] * o[nt][j];
    ss += __shfl_xor(ss, 16); ss += __shfl_xor(ss, 32);
    float* ssq = bl;
    if (lane < 16) ssq[wave * 16 + lane] = ss;
    __syncthreads();
    const float rs = rsqrtf((ssq[mtw * 16 + fr] + ssq[(mtw + 4) * 16 + fr]) * (1.f / 128.f) + 1e-6f);
    bf16_t* Z = (bf16_t*)(p->ws + WS_GU);
    const int row = row0 + mtw * 16 + fr;
#pragma unroll
    for (int nt = 0; nt < 4; ++nt) { const int e = nh * 64 + nt * 16 + 4 * fq;
        const uint2 rr = *(const uint2*)(P + O_GR + (size_t)((b * 4 + h) * RB + c * 64 + mtw * 16 + fr) * 128 + e); const float4 ng = *(const float4*)(p->in[24] + layer * 128 + e);
        const float r0 = bf2f(rr.x & 0xFFFFu), r1 = bf2f(rr.x >> 16), r2 = bf2f(rr.y & 0xFFFFu), r3 = bf2f(rr.y >> 16);
        uint2 w; w.x = pk2(o[nt][0] * rs * ng.x * r0 * sigm(r0), o[nt][1] * rs * ng.y * r1 * sigm(r1)); w.y = pk2(o[nt][2] * rs * ng.z * r2 * sigm(r2), o[nt][3] * rs * ng.w * r3 * sigm(r3));
        *(uint2*)(Z + (size_t)row * 512 + h * 128 + e) = w; }
}

__device__ __forceinline__ void phase_merge_h(KP p, int layer, int bid, int nb) {
    const char* H = (const char*)(p->ws + WS_HKV); const bf16_t* WT = (const bf16_t*)(p->ws + WS_WT); bf16_t* M = (bf16_t*)(p->ws + WS_PROJ + PJ_MERGED);
    f32x4 accm[2][4][2]; uint2 brp[2][4][2];
    LAS unsigned char* gbl = (LAS unsigned char*)smem + 147456;
    auto tile_of = [&](int j, int& pm, int& pn) -> bool { int q;
        if (xcd_unit(bid, nb, j, 128, 8, q, pn)) { pm = (q >> 5) * 33 + 1 + (q & 31); return true; }
        if (layer != 0 || bid >= 32) return false;
        int q2, pn2; if (j > 0 && !xcd_unit(bid, nb, j - 1, 128, 8, q2, pn2)) return false;
        pm = (bid >> 3) * 33; pn = bid & 7; return true; };
    gemm256h3(smem,
        [&](int i, U256& u) -> bool { int pm, pn; if (!tile_of(i >> 3, pm, pn)) return false; const int sub = i & 7, br = sub >> 1;
            if (!(sub & 1)) { const char* Zb; size_t wo; int Kb;
                if (br == 0) { Zb = (const char*)(p->ws + WS_ZS5); wo = WT_WS5O; Kb = 256; } else if (br == 1) { Zb = (const char*)(p->ws + WS_GU); wo = WT_WGLAO; Kb = 512; }
                else if (br == 2) { Zb = (const char*)(p->ws + WS_ZNA); wo = WT_WNAO; Kb = 256; } else { Zb = (const char*)(p->ws + WS_ZCV); wo = WT_WCVO; Kb = 256; }
                u.A = Zb + (size_t)pm * 256 * Kb * 2; u.B = (const char*)(WT + wo) + (size_t)pn * 128 * Kb * 2; u.K = Kb; u.f8 = 0; }
            else { u.A = (const char*)p->out + OUT_H8 + (size_t)pm * 256 * D; u.B = (const char*)(p->ws + WS_WG8) + (size_t)(br * 1024 + pn * 128) * D; u.K = D / 2; u.f8 = 1; }
            return true; },
        [&](int i, f32x4 (&acc)[2][4][2], int wr, int wc, int fr, int fq) {
            int pm, pn; tile_of(i >> 3, pm, pn); const int sub = i & 7, br = sub >> 1;
            if (!(sub & 1)) {
#pragma unroll
                for (int ai = 0; ai < 2; ++ai)
#pragma unroll
                    for (int m = 0; m < 4; ++m)
#pragma unroll
                        for (int n = 0; n < 2; ++n) { brp[ai][m][n].x = pk2(acc[ai][m][n][0], acc[ai][m][n][1]); brp[ai][m][n].y = pk2(acc[ai][m][n][2], acc[ai][m][n][3]); }
                __builtin_amdgcn_global_load_lds((const unsigned*)(p->in[9] + (size_t)layer * 4096 + br * 1024 + pn * 128 + wc * 32 + ((fq & 1) * 16 + fr)), (LAS unsigned*)(gbl + (wr * 4 + wc) * 256), 4, 0, 0);
            } else {
                constexpr float NL2E = -1.4426950408889634f, NL2E_A = NL2E / 32.f;
                const LAS f32x4* bl = (const LAS f32x4*)(gbl + (wr * 4 + wc) * 256);
                const f32x4 gb0 = bl[fq], gb1 = bl[4 + fq];
                const float4 b0 = {gb0[0] * NL2E, gb0[1] * NL2E, gb0[2] * NL2E, gb0[3] * NL2E}, b1 = {gb1[0] * NL2E, gb1[1] * NL2E, gb1[2] * NL2E, gb1[3] * NL2E};
#pragma unroll
                for (int ai = 0; ai < 2; ++ai)
#pragma unroll
                    for (int m = 0; m < 4; ++m)
#pragma unroll
                        for (int n = 0; n < 2; ++n) { const f32x4 v = acc[ai][m][n]; const float4 bb = n ? b1 : b0; const uint2 bp = brp[ai][m][n];
                            const float s0 = __builtin_amdgcn_rcpf(1.f + __builtin_amdgcn_exp2f(__builtin_fmaf(v[0], NL2E_A, bb.x))), s1 = __builtin_amdgcn_rcpf(1.f + __builtin_amdgcn_exp2f(__builtin_fmaf(v[1], NL2E_A, bb.y))),
                                        s2 = __builtin_amdgcn_rcpf(1.f + __builtin_amdgcn_exp2f(__builtin_fmaf(v[2], NL2E_A, bb.z))), s3 = __builtin_amdgcn_rcpf(1.f + __builtin_amdgcn_exp2f(__builtin_fmaf(v[3], NL2E_A, bb.w)));
                            const float t0 = bf2f(bp.x & 0xFFFFu), t1 = bf2f(bp.x >> 16), t2 = bf2f(bp.y & 0xFFFFu), t3 = bf2f(bp.y >> 16);
                            if (br == 0) accm[ai][m][n] = (f32x4){s0 * t0, s1 * t1, s2 * t2, s3 * t3};
                            else { accm[ai][m][n][0] = __builtin_fmaf(s0, t0, accm[ai][m][n][0]); accm[ai][m][n][1] = __builtin_fmaf(s1, t1, accm[ai][m][n][1]);
                                   accm[ai][m][n][2] = __builtin_fmaf(s2, t2, accm[ai][m][n][2]); accm[ai][m][n][3] = __builtin_fmaf(s3, t3, accm[ai][m][n][3]); } }
                if (br == 3) {
                    bf16_t* mrow = M + (size_t)(pm * 256 + wr * 64 + fr) * D + pn * 128 + wc * 32 + fq * 4;
#pragma unroll
                    for (int ai = 0; ai < 2; ++ai)
#pragma unroll
                        for (int m = 0; m < 4; ++m)
#pragma unroll
                            for (int n = 0; n < 2; ++n) { uint2 o; o.x = pk2(accm[ai][m][n][0], accm[ai][m][n][1]); o.y = pk2(accm[ai][m][n][2], accm[ai][m][n][3]);
                                *(uint2*)(mrow + (size_t)(ai * 128 + m * 16) * D + n * 16) = o; }
                }
            } });
}
__device__ __forceinline__ void phase_mix_ctx(KP p, int layer, int bid, int nb) {
    typedef GT<256, 128, 4, 2> G;
    const int tid = tidx(), lane = tid & 63, wave = tid >> 6, wm = wave >> 1, wn = wave & 1, fr = lane & 15, fq = lane >> 4;
    const bf16_t* M = (const bf16_t*)(p->ws + WS_PROJ + PJ_MERGED); const bf16_t* W = (const bf16_t*)(p->ws + WS_WT) + WT_WMIX;
    const int nunit = 4 * 8;
    gemm_stream<256, 128, 4, 2>(
        [&](int s, cbfp (&ap)[G::AI], long& kstep, cbfp (&bp)[G::BI], int& nk) -> bool {
            const int u = bid + s * nb; if (u >= nunit) return false; const int q = u >> 3, pn = u & 7, pm = q * 33;
#pragma unroll
            for (int i = 0; i < G::AI; ++i) ap[i] = M + (size_t)(pm * 256 + st_row(i)) * D + st_chunk(i) * 8;
#pragma unroll
            for (int i = 0; i < G::BI; ++i) bp[i] = W + (size_t)(pn * 128 + st_row(i)) * D + st_chunk(i) * 8;
            kstep = 64; nk = 16; return true; },
        [&](int s, f32x4 (&acc)[G::MT][G::NTL]) {
            const int u = bid + s * nb, q = u >> 3, pn = u & 7, pm = q * 33;
            const float* g1 = mod_vec(p, layer, pm * 256) + 2048;
#pragma unroll
            for (int mt = 0; mt < G::MT; ++mt)
#pragma unroll
                for (int nt = 0; nt < G::NTL; ++nt) { const int row = pm * 256 + wm * 64 + mt * 16 + fr, col = pn * 128 + wn * 64 + nt * 16 + fq * 4;
                    const float4 xo = *(const float4*)(xsrc_row(p, layer, row) + col), gg = *(const float4*)(g1 + col);
                    *(float4*)(xdst_row(p, row) + col) = make_float4(xo.x + gg.x * acc[mt][nt][0], xo.y + gg.y * acc[mt][nt][1], xo.z + gg.z * acc[mt][nt][2], xo.w + gg.w * acc[mt][nt][3]); }
            ZERO_ACC(acc, G::MT, G::NTL); },
        smem);
}

__device__ __forceinline__ void phase_mix256(KP p, int layer, int bid, int nb, bool live = true) {
    const char* M = (const char*)(p->ws + WS_PROJ + PJ_MERGED); const char* W = (const char*)((const bf16_t*)(p->ws + WS_WT) + WT_WMIX);
    gemm256(smem,
        [&](int i, U256& u) -> bool { int q, pn; if (!xcd_unit(bid, nb, i, 128, 4, q, pn)) return false; const int pm = (q >> 5) * 33 + 1 + (q & 31);
            u.A = M + (size_t)pm * 256 * D * 2; u.B = W + (size_t)pn * 256 * D * 2; u.K = D; return true; },
        [&](int i, f32x4 (&acc)[2][2][4][2], int wr, int wc, int fr, int fq) {
            int q, pn; xcd_unit(bid, nb, i, 128, 4, q, pn); const int pm = (q >> 5) * 33 + 1 + (q & 31);
            const float* g1 = mod_vec(p, layer, pm * 256) + 2048 + pn * 256 + wc * 32 + fq * 4;
            const size_t eoff = (size_t)(wr * 64 + fr) * D + pn * 256 + wc * 32 + fq * 4;
            const float* xs = p->in[0] + (size_t)((pm / 33) * SEQ + (pm % 33 - 1) * 256) * D + eoff; bf16_t* xd = xb_row(p, pm * 256) + eoff;
#pragma unroll
            for (int bj = 0; bj < 2; ++bj)
#pragma unroll
                for (int n = 0; n < 2; ++n) { const float4 gg = *(const float4*)(g1 + bj * 128 + n * 16);
#pragma unroll
                    for (int ai = 0; ai < 2; ++ai)
#pragma unroll
                        for (int m = 0; m < 4; ++m) { const size_t o = (size_t)(ai * 128 + m * 16) * D + bj * 128 + n * 16; const f32x4 v = acc[ai][bj][m][n];
                            const float4 xo = layer == 0 ? *(const float4*)(xs + o) : bf4(*(const uint2*)(xd + o));
                            uint2 w; w.x = pk2(xo.x + gg.x * v[0], xo.y + gg.y * v[1]); w.y = pk2(xo.z + gg.z * v[2], xo.w + gg.w * v[3]);
                            if (live) *(uint2*)(xd + o) = w; } } });
}

__device__ __forceinline__ void moe_tiles(KP p, int layer, int* tt) {
    __syncthreads();
    if (tidx() == 0) { const unsigned* cnt = (const unsigned*)(p->ws + WS_CTL + CTL_CNT) + layer * 128 * 64; int n = 0;
        for (int c = 0; c < NCLS; ++c) { const int k = (int)__hip_atomic_load(cnt + c * 64, __ATOMIC_RELAXED, __HIP_MEMORY_SCOPE_AGENT);
            for (int r0 = 0; r0 < k && n < MAXTILES; r0 += 128) { tt[1 + 2 * n] = c; tt[2 + 2 * n] = r0; ++n; } }
        tt[0] = n; }
    __syncthreads();
}
__device__ __forceinline__ int moe_unit(int bid, int nb, int s) { const int nrank = nb >> 3; return (s * 8 + (bid & 7)) * nrank + (bid >> 3); }
__device__ __forceinline__ void cls_experts(int cls, int& ea, int& eb) {
    const int gi = cls / 28; int q = cls % 28, a = 0;
    while (q >= 7 - a) { q -= 7 - a; ++a; }
    ea = gi * 8 + a; eb = gi * 8 + a + 1 + q;
}
__device__ __forceinline__ void phase_moe_up(KP p, int layer, const int* tt, int bid, int nb) {
    const int nunit = tt[0] * 4;
    const char* H8 = (const char*)p->out + OUT_H8; bf16_t* ACT = (bf16_t*)(p->ws + WS_PROJ + PJ_ACT); const float2* tokw = (const float2*)(p->ws + WS_PROJ + PJ_TOKW);
    const unsigned* cnts = (const unsigned*)(p->ws + WS_CTL + CTL_CNT) + layer * 128 * 64;
    gemm256h3g(smem,
        [&](int i, U256& u) -> bool { const int un = moe_unit(bid, nb, i); if (un >= nunit) return false;
            const int tile = un >> 2, pn = un & 3, cls = tt[1 + 2 * tile], r0 = tt[2 + 2 * tile], slot = pn >> 1, hf = pn & 1, cnt = (int)cnts[cls * 64];
            int ea, eb; cls_experts(cls, ea, eb); const int ex = slot ? eb : ea;
            u.A = (const char*)((const bf16_t*)(p->ws + WS_WT) + WT_W13) + ((size_t)ex * 512 + (size_t)hf * 256) * 1024; u.B = H8; u.K = D / 2; u.f8 = 1;
            u.gidx = (const int*)(p->ws + WS_PROJ + PJ_PERM) + (size_t)cls * MOE_CAP + r0; u.gmax = cnt - r0; return true; },
        [&](int i, f32x4 (&acc)[2][4][2], int wr, int wc, int fr, int fq) {
            const int un = moe_unit(bid, nb, i), tile = un >> 2, pn = un & 3, cls = tt[1 + 2 * tile], r0 = tt[2 + 2 * tile], slot = pn >> 1, hf = pn & 1, cnt = (int)cnts[cls * 64];
            const int* perm = (const int*)(p->ws + WS_PROJ + PJ_PERM) + (size_t)cls * MOE_CAP;
#pragma unroll
            for (int n = 0; n < 2; ++n) { const int tk = wc * 32 + n * 16 + fr; const bool ok = r0 + tk < cnt; float w = 0.f;
                if (ok) { const float2 tw = tokw[perm[r0 + tk]]; w = (slot ? tw.y : tw.x) * (1.f / 32.f); }
                bf16_t* arow = ACT + ((size_t)tile * 128 + tk) * 512 + slot * 256 + hf * 128 + wr * 64 + fq * 4;
#pragma unroll
                for (int m = 0; m < 4; ++m) { const f32x4 a = acc[0][m][n], bq = acc[1][m][n]; uint2 o = make_uint2(0u, 0u);
                    if (ok) { const float a0 = a[0] * (1.f / 32.f), a1 = a[1] * (1.f / 32.f), a2 = a[2] * (1.f / 32.f), a3 = a[3] * (1.f / 32.f);
                        o.x = pk2(a0 * sigm(a0) * bq[0] * w, a1 * sigm(a1) * bq[1] * w); o.y = pk2(a2 * sigm(a2) * bq[2] * w, a3 * sigm(a3) * bq[3] * w); }
                    *(uint2*)(arow + m * 16) = o; } } });
}
__device__ __forceinline__ void phase_moe_down(KP p, int layer, const int* tt, int bid, int nb, bool live = true) {
    typedef GT<128, 256, 2, 4> G;
    const int tid = tidx(), lane = tid & 63, wave = tid >> 6, wm = wave >> 2, wn = wave & 3, fr = lane & 15, fq = lane >> 4;
    const int nunit = tt[0] * 4;
    const bf16_t* ACT = (const bf16_t*)(p->ws + WS_PROJ + PJ_ACT); const bf16_t* W2 = (const bf16_t*)(p->ws + WS_WT) + WT_W2;
    const unsigned* cnts = (const unsigned*)(p->ws + WS_CTL + CTL_CNT) + layer * 128 * 64;
    gemm_stream<128, 256, 2, 4>(
        [&](int s, cbfp (&ap)[G::AI], long& kstep, cbfp (&bp)[G::BI], int& nk) -> bool {
            const int u = moe_unit(bid, nb, s >> 1); if (u >= nunit) return false; const int slot = s & 1, tile = u >> 2, pn = u & 3, cls = tt[1 + 2 * tile];
            int ea, eb; cls_experts(cls, ea, eb);
#pragma unroll
            for (int i = 0; i < G::AI; ++i) ap[i] = ACT + ((size_t)tile * 128 + st_row(i)) * 512 + slot * 256 + st_chunk(i) * 8;
#pragma unroll
            for (int i = 0; i < G::BI; ++i) bp[i] = W2 + (size_t)(slot ? eb : ea) * 1024 * 256 + (size_t)(pn * 256 + st_row(i)) * 256 + st_chunk(i) * 8;
            kstep = 64; nk = 4; return true; },
        [&](int s, f32x4 (&acc)[G::MT][G::NTL]) {
            if (!(s & 1)) return;
            const int u = moe_unit(bid, nb, s >> 1), tile = u >> 2, pn = u & 3, cls = tt[1 + 2 * tile], r0 = tt[2 + 2 * tile], cnt = (int)cnts[cls * 64];
            const int* perm = (const int*)(p->ws + WS_PROJ + PJ_PERM) + (size_t)cls * MOE_CAP;
#pragma unroll
            for (int mt = 0; mt < G::MT; ++mt) { const int rl = wm * 64 + mt * 16 + fr;
                if (r0 + rl < cnt) { const int row = perm[r0 + rl]; const float* g2 = mod_vec(p, layer, row) + 5120;
                    if (row % RB < CTX) { float* xr = xdst_row(p, row);
#pragma unroll
                        for (int nt = 0; nt < G::NTL; ++nt) { const int col = pn * 256 + wn * 64 + nt * 16 + fq * 4; const float4 gg = *(const float4*)(g2 + col); float4 xo = *(float4*)(xr + col);
                            xo.x += gg.x * acc[mt][nt][0]; xo.y += gg.y * acc[mt][nt][1]; xo.z += gg.z * acc[mt][nt][2]; xo.w += gg.w * acc[mt][nt][3]; if (live) *(float4*)(xr + col) = xo; }
                    } else { const bf16_t* xr = xb_row(p, row); bf16_t* xw = x2_row(p, layer, row);
#pragma unroll
                        for (int nt = 0; nt < G::NTL; ++nt) { const int col = pn * 256 + wn * 64 + nt * 16 + fq * 4; const float4 gg = *(const float4*)(g2 + col); const float4 xo = bf4(*(const uint2*)(xr + col));
                            uint2 w; w.x = pk2(xo.x + gg.x * acc[mt][nt][0], xo.y + gg.y * acc[mt][nt][1]); w.y = pk2(xo.z + gg.z * acc[mt][nt][2], xo.w + gg.w * acc[mt][nt][3]); if (live) *(uint2*)(xw + col) = w; } } } }
            ZERO_ACC(acc, G::MT, G::NTL); },
        smem);
}

__device__ __forceinline__ void phase_final_norm(KP p) {
    const int wave = tidx() >> 6, lane = tidx() & 63;
    const float* g = p->in[40];
    for (int row = blockIdx.x * 8 + wave; row < NB * SEQ; row += gridDim.x * 8) {
        float4* xr = (float4*)(p->out + (size_t)row * D); const uint2* xi = (const uint2*)((const bf16_t*)(p->ws + WS_HKV) + (size_t)row * D);
        float4 v[4]; float ss = 0.f;
#pragma unroll
        for (int i = 0; i < 4; ++i) { v[i] = bf4(xi[lane + 64 * i]); ss += v[i].x * v[i].x + v[i].y * v[i].y + v[i].z * v[i].z + v[i].w * v[i].w; }
        ss = wave_sum(ss);
        const float rs = rsqrtf(ss * (1.f / D) + 1e-6f);
#pragma unroll
        for (int i = 0; i < 4; ++i) { const float4 gg = ((const float4*)g)[lane + 64 * i];
            xr[lane + 64 * i] = make_float4(v[i].x * rs * gg.x, v[i].y * rs * gg.y, v[i].z * rs * gg.z, v[i].w * rs * gg.w); }
    }
}

#ifndef EN_S5
#define EN_S5 1
#endif
#ifndef EN_GLA
#define EN_GLA 1
#endif
#ifndef EN_NA
#define EN_NA 1
#endif
#ifndef EN_CV
#define EN_CV 1
#endif
#ifndef EN_MIX
#define EN_MIX 1
#endif
#ifndef EN_MOE
#define EN_MOE 1
#endif

__device__ __forceinline__ KP fresh_params(KP q) { asm volatile("" : "+s"(q)); return q; }
__global__ void __launch_bounds__(NT, 2) fwd(Params pv) {
    KP pp = (KP)__builtin_amdgcn_kernarg_segment_ptr();
    asm volatile("" : "+s"(pp));
    KP p = pp;
#define PF (fresh_params(pp))
    LAS unsigned* xbw = (LAS unsigned*)(smem + LDS_BYTES - 16);
    if (tidx() == 0) { xbw[0] = 0u; xbw[1] = 0u; xbw[2] = 0u; xbw[3] = 0u; }
    __syncthreads();
    XcdBarrier bar = xcd_barrier_post(pp, (volatile LAS unsigned*)xbw);
    const int bid = blockIdx.x, nb = gridDim.x;

    for (int u = bid; u < 192 + 9 + 32; u += nb) {
        if (u < 32) unit_s5w(PF, u);
        else if (u < 224) unit_mod(PF, u - 32);
        else unit_tables(PF, u - 224);
    }
    __syncthreads();
    if (nb <= 64) { for (int t = (nb - 1 - bid) * 8 + (tidx() >> 6); t < CV_TILES; t += nb * 8) wave_convert(PF, 0, t); }
    else if (bid >= 32) { for (int t = (nb - 1 - bid) * 8 + (tidx() >> 6); t < CV_TILES; t += (nb - 32) * 8) wave_convert(PF, 0, t); }
    xcd_barrier(bar);

#pragma unroll 1
    for (int layer = 0; layer < 2; ++layer) {
        phase_norm(PF, layer, 0, bid, nb);
        if (layer == 1) { __syncthreads(); for (int t = bid * 8 + (tidx() >> 6); t < CV_TILES; t += nb * 8) wave_convert(PF, 1, t); }
        xcd_barrier(bar);
#if EN_MIX
        phase_inproj(PF, bid, nb);
        xcd_barrier(bar);
        {
            const int n_na = EN_NA ? (layer == 0 ? 2112 : 2048) : 0, n_g1 = EN_GLA ? 2112 : 0, n_cv = EN_CV ? 528 : 0;
            for (int u = bid; u < n_na + n_g1 + n_cv; u += nb) {
                if (u < n_na) unit_na(PF, layer, u);
                else if (u < n_na + n_g1) unit_gla_g1(PF, layer, u - n_na);
                else unit_conv(PF, layer, u - n_na - n_g1);
            }
            if (EN_S5) phase_s5_gemm1(PF, layer, nb - 1 - bid, nb);
        }
        xcd_barrier(bar);
        {
            const int n_s = EN_S5 ? 128 : 0, n_g = EN_GLA ? 256 : 0;
            for (int u = bid; u < n_s + n_g; u += nb) { if (u < n_s) unit_s5_scan(PF, layer, u); else unit_gla_g2(PF, layer, u - n_s); }
        }
        xcd_barrier(bar);
        {
            const int n_g3 = EN_GLA ? 2112 : 0;
            for (int u = bid; u < n_g3; u += nb) unit_gla_g3(PF, layer, u);
            if (EN_S5) phase_s5_gemm2(PF, layer, nb - 1 - bid, nb);
        }
        xcd_barrier(bar);
        if (EN_S5) phase_s5_glu(PF, layer, bid, nb);
        xcd_barrier(bar);
        phase_merge_h(PF, layer, bid, nb);
        xcd_barrier(bar);
        if (layer == 0) phase_mix_ctx(PF, layer, nb - 1 - bid, nb);
        phase_mix256(PF, layer, bid, nb);
        xcd_barrier(bar);
#else
        if (layer == 0) {
            for (int r = bid * 8 + (tidx() >> 6); r < R; r += nb * 8) { const float4* s = (const float4*)xsrc_row(p, 0, r); float4* d = (float4*)xdst_row(p, r);
                for (int i = tidx() & 63; i < 256; i += 64) d[i] = s[i]; }
            xcd_barrier(bar);
        }
#endif
#if EN_MOE
        phase_norm(PF, layer, 1, bid, nb);
        xcd_barrier(bar);
        int* tt = (int*)(smem + LDS_BYTES - 4096);
        moe_tiles(PF, layer, tt);
        phase_moe_up(PF, layer, tt, bid, nb);
        xcd_barrier(bar);
        phase_moe_down(PF, layer, tt, bid, nb);
        xcd_barrier(bar);
#endif
    }
    phase_final_norm(PF);
}

extern "C" void kernel_launch(void* const* d_in, const int* in_sizes, int n_in, void* d_out, int out_size, void* d_ws, size_t ws_size, hipStream_t stream) {
    static int grid = 0;
    if (grid == 0) {
        int dev = 0, cus = 0, per_cu = 0;
        if (n_in != 41 || out_size != NB * SEQ * D || ws_size < WS_END) { fprintf(stderr, "kernel_launch: unexpected shapes (n_in %d out %d ws %zu need %zu)\n", n_in, out_size, ws_size, (size_t)WS_END); grid = -1; return; }
        if (hipGetDevice(&dev) != hipSuccess || hipDeviceGetAttribute(&cus, hipDeviceAttributeMultiprocessorCount, dev) != hipSuccess) { grid = -1; return; }
        if (hipFuncSetAttribute((const void*)fwd, hipFuncAttributeMaxDynamicSharedMemorySize, LDS_BYTES) != hipSuccess) { grid = -1; return; }
        if (hipOccupancyMaxActiveBlocksPerMultiprocessor(&per_cu, (const void*)fwd, NT, LDS_BYTES) != hipSuccess || per_cu < 1) per_cu = 1;
        (void)hipGetLastError();
        grid = cus & ~7;
    }
    if (grid < 0) return;
    (void)hipMemsetAsync(d_ws, 0, CTL_BYTES, stream);
    Params p{};
    for (int i = 0; i < 41; ++i) p.in[i] = (const float*)d_in[i];
    p.out = (float*)d_out; p.ws = (unsigned char*)d_ws;
    hipLaunchKernelGGL(fwd, dim3(grid), dim3(NT), LDS_BYTES, stream, p);
}
```

```cpp
#include <hip/hip_runtime.h>
#include <cstdio>
#include <cstdint>

#define XB_TMO      128
#define XB_XCNT(j)  (256  + 64 * (j))
#define XB_XSUB(j)  (1280 + 64 * (j))
#define XB_XGEN(j)  (2304 + 64 * (j))
#define XB_TOP      3328
#define XB_TOPGEN   3392
#define XCD_BAR_WORDS 3456
#define XB_SPIN_CAP (1u << 18)
#define LAS __attribute__((address_space(3)))

__device__ __forceinline__ unsigned xb_ld(unsigned* p)              { return __hip_atomic_load(p, __ATOMIC_RELAXED, __HIP_MEMORY_SCOPE_AGENT); }
__device__ __forceinline__ unsigned xb_add(unsigned* p, unsigned v) { return __hip_atomic_fetch_add(p, v, __ATOMIC_RELAXED, __HIP_MEMORY_SCOPE_AGENT); }
__device__ __forceinline__ unsigned xb_xcc_id() { return (unsigned)__builtin_amdgcn_s_getreg((3 << 11) | 20) & 0xFu; }
#define XB_SPIN(cond, bar) do { unsigned _sp = 0; while (cond) { __builtin_amdgcn_s_sleep(1); \
    if ((++_sp & 255u) == 0u) { if (xb_ld(&(bar)[XB_TMO])) break; if (_sp > XB_SPIN_CAP) { atomicAdd(&(bar)[XB_TMO], 1u); break; } } } } while (0)

struct Params;
struct XcdBarrier { const __attribute__((address_space(4))) Params* kp; volatile LAS unsigned* st; };

__device__ __forceinline__ unsigned* xb_words(const __attribute__((address_space(4))) Params* kp);
__device__ __forceinline__ XcdBarrier xcd_barrier_post(const __attribute__((address_space(4))) Params* kp, volatile LAS unsigned* st) {
    XcdBarrier b; b.kp = kp; b.st = st;
    if (threadIdx.x == 0) (void)xb_add(&xb_words(kp)[XB_XCNT(xb_xcc_id())], 1u);
    return b;
}
__device__ __forceinline__ void xcd_barrier_complete(unsigned* bar, unsigned x, unsigned& nloc, unsigned& nx) {
    const unsigned G = gridDim.x * gridDim.y * gridDim.z;
    unsigned sum, cnt, mine, sp = 0u;
    for (;;) {
        sum = 0u; cnt = 0u; mine = 0u;
#pragma unroll
        for (unsigned j = 0; j < 16; ++j) { const unsigned c = xb_ld(&bar[XB_XCNT(j)]); sum += c; cnt += (c > 0u) ? 1u : 0u; mine = (j == x) ? c : mine; }
        if (sum == G) break;
        __builtin_amdgcn_s_sleep(1);
        if ((++sp & 255u) == 0u) { if (xb_ld(&bar[XB_TMO])) break; if (sp > XB_SPIN_CAP) { atomicAdd(&bar[XB_TMO], 1u); break; } }
    }
    nloc = mine > 0u ? mine : 1u; nx = cnt > 0u ? cnt : 1u;
}
__device__ __forceinline__ void xcd_barrier(const XcdBarrier& b) {
    asm volatile("s_waitcnt vmcnt(0)" ::: "memory");
    __syncthreads();
    if (threadIdx.x == 0) {
        unsigned* bar = xb_words(b.kp); const unsigned bx = xb_xcc_id();
        __builtin_amdgcn_s_waitcnt(0);
        unsigned nloc = b.st[0], nx = b.st[1];
        if (nloc == 0u) { xcd_barrier_complete(bar, bx, nloc, nx); b.st[0] = nloc; b.st[1] = nx; }
        const unsigned old = xb_add(&bar[XB_XSUB(bx)], 1u);
        const unsigned gen = old / nloc;
        if (old + 1u == (gen + 1u) * nloc) {
            __builtin_amdgcn_fence(__ATOMIC_RELEASE, "agent");
            asm volatile("s_waitcnt vmcnt(0)" ::: "memory");
            const unsigned og = xb_add(&bar[XB_TOP], 1u);
            const unsigned tg = og / nx;
            if (og + 1u == (tg + 1u) * nx) xb_add(&bar[XB_TOPGEN], 1u);
            else XB_SPIN(xb_ld(&bar[XB_TOPGEN]) == tg, bar);
            __builtin_amdgcn_fence(__ATOMIC_ACQUIRE, "agent");
            xb_add(&bar[XB_XGEN(bx)], 1u);
            asm volatile("s_waitcnt vmcnt(0)" ::: "memory");
        } else {
            XB_SPIN(xb_ld(&bar[XB_XGEN(bx)]) == gen, bar);
            __builtin_amdgcn_fence(__ATOMIC_ACQUIRE, "agent");
            asm volatile("s_waitcnt vmcnt(0)" ::: "memory");
        }
    }
    __syncthreads();
}

typedef unsigned short bf16_t;
typedef short bf16x8 __attribute__((ext_vector_type(8)));
typedef float f32x4 __attribute__((ext_vector_type(4)));
typedef long l64x2 __attribute__((ext_vector_type(2)));
typedef int i32x4 __attribute__((ext_vector_type(4)));
typedef int i32x8 __attribute__((ext_vector_type(8)));
typedef unsigned u32x4 __attribute__((ext_vector_type(4)));

constexpr int D = 1024, NB = 4, SEQ = 8192, CTX = 256, RB = CTX + SEQ, R = NB * RB;
constexpr int NT = 512;
constexpr int LDS_BYTES = 163840;
constexpr int NPROJ = 3104;
constexpr size_t O_U = 0, O_GQ = (size_t)4 * 8448 * 256, O_GK = (size_t)4 * 8448 * 512, O_GV = (size_t)4 * 8448 * 768, O_GR = (size_t)4 * 8448 * 1280, O_GA = (size_t)4 * 8448 * 1792,
                 O_NQ = (size_t)4 * 8448 * 1824, O_NK = (size_t)4 * 8448 * 2080, O_NV = (size_t)4 * 8448 * 2336, O_CV = (size_t)4 * 8448 * 2592;
constexpr int C_S5U = 0, C_GQ = 256, C_GK = 512, C_GV = 768, C_GR = 1280, C_GA = 1792, C_NQ = 1824, C_NK = 2080, C_NV = 2336, C_CV = 2592;
constexpr int NCH16 = R / 16;
constexpr int NCH64 = R / 64;
constexpr int MOE_CAP = R;
constexpr int NCLS = 112;
constexpr int MAXTILES = 376;

constexpr size_t WS_CTL = 0;
constexpr size_t CTL_BYTES = 16384 + 65536;
constexpr size_t CTL_CNT = 16384;
constexpr size_t WS_MOD = 16384 + 65536;
constexpr size_t WS_ROPE = WS_MOD + 245760;
constexpr size_t WS_WR = WS_ROPE + 24576;
constexpr size_t WS_A16 = WS_WR + 294912;
constexpr size_t WS_S5W1 = WS_A16 + 32768;
constexpr size_t WS_S5W2 = WS_S5W1 + 8388608;
constexpr size_t WS_WT = WS_S5W2 + 4194304;
constexpr size_t WT_WIN = 0, WT_WG = 3276800, WT_WMIX = 7471104, WT_WGLU = 8519680, WT_WS5O = 8585216, WT_WGLAO = 8847360, WT_WNAO = 9371648, WT_WCVO = 9633792,
                 WT_W13 = 9895936, WT_W2 = 26673152, WT_ELEMS = 35061760;
constexpr size_t WS_HKV = WS_WT + WT_ELEMS * 2;
constexpr size_t WS_PROJ = WS_HKV + 69206016;
constexpr size_t PJ_MERGED = 0, PJ_ACT = 69206016, PJ_PERM = PJ_ACT + 49283072, PJ_TOKW = PJ_PERM + 15138816;
constexpr size_t WS_DECAY = WS_PROJ + 209780736;
constexpr size_t WS_YSUM = WS_DECAY + 1081344;
constexpr size_t WS_GU = WS_YSUM + 17301504;
constexpr size_t WS_HIN = WS_GU + 34603008;
constexpr size_t WS_ZS5 = WS_HIN + 17301504;
constexpr size_t WS_ZNA = WS_ZS5 + 17301504;
constexpr size_t WS_ZCV = WS_ZNA + 17301504;
constexpr size_t WS_XC = WS_ZCV + 17301504;
constexpr size_t WS_BC = WS_XC + 4194304;
constexpr size_t WS_GWB = WS_BC + 34603008;
constexpr size_t WS_WG8 = WS_GWB + 81920;
constexpr size_t WS_END = WS_WG8 + 4194304;
constexpr size_t OUT_H8 = 75497472;

struct Params {
    const float* in[41];
    float* out;
    unsigned char* ws;
};

typedef const __attribute__((address_space(4))) Params* KP;
__device__ __forceinline__ unsigned* xb_words(KP kp) { return (unsigned*)kp->ws; }
extern __shared__ __attribute__((aligned(16))) unsigned char smem[];

__device__ __forceinline__ int tidx() { int t = threadIdx.x; asm volatile("" : "+v"(t)); return t; }
__device__ __forceinline__ float bf2f(unsigned v) { return __uint_as_float(v << 16); }
typedef __bf16 bf16x2_t __attribute__((ext_vector_type(2)));
__device__ __forceinline__ unsigned pk2(float a, float b) { const bf16x2_t v = {(__bf16)a, (__bf16)b}; return __builtin_bit_cast(unsigned, v); }
__device__ __forceinline__ unsigned f2bf(float f) { return (unsigned)__builtin_bit_cast(unsigned short, (__bf16)f); }
__device__ __forceinline__ float sigm(float x) { return __builtin_amdgcn_rcpf(1.f + __expf(-x)); }
__device__ __forceinline__ float gelu_t(float x) { return x * sigm(1.5957691216057308f * (x + 0.044715f * x * x * x)); }
template <int CTRL> __device__ __forceinline__ float dpp_f(float v) { return __int_as_float(__builtin_amdgcn_update_dpp(0, __float_as_int(v), CTRL, 0xF, 0xF, true)); }
__device__ __forceinline__ float row16_sum(float v) { v += dpp_f<0xB1>(v); v += dpp_f<0x4E>(v); v += dpp_f<0x141>(v); v += dpp_f<0x140>(v); return v; }
__device__ __forceinline__ float row16_max(float v) { v = fmaxf(v, dpp_f<0xB1>(v)); v = fmaxf(v, dpp_f<0x4E>(v)); v = fmaxf(v, dpp_f<0x141>(v)); v = fmaxf(v, dpp_f<0x140>(v)); return v; }
__device__ __forceinline__ float wave_prefix_sum(float v) {
    v += dpp_f<0x111>(v); v += dpp_f<0x112>(v); v += dpp_f<0x114>(v); v += dpp_f<0x118>(v);
    const float t0 = __int_as_float(__builtin_amdgcn_readlane(__float_as_int(v), 15)), t1 = __int_as_float(__builtin_amdgcn_readlane(__float_as_int(v), 31)), t2 = __int_as_float(__builtin_amdgcn_readlane(__float_as_int(v), 47));
    const int row = (int)(threadIdx.x & 63) >> 4;
    return v + (row >= 1 ? t0 : 0.f) + (row >= 2 ? t1 : 0.f) + (row >= 3 ? t2 : 0.f);
}
__device__ __forceinline__ float wave_suffix_sum(float v) {
    v += dpp_f<0x101>(v); v += dpp_f<0x102>(v); v += dpp_f<0x104>(v); v += dpp_f<0x108>(v);
    const float t1 = __int_as_float(__builtin_amdgcn_readlane(__float_as_int(v), 16)), t2 = __int_as_float(__builtin_amdgcn_readlane(__float_as_int(v), 32)), t3 = __int_as_float(__builtin_amdgcn_readlane(__float_as_int(v), 48));
    const int row = (int)(threadIdx.x & 63) >> 4;
    return v + (row <= 2 ? t3 : 0.f) + (row <= 1 ? t2 : 0.f) + (row <= 0 ? t1 : 0.f);
}
__device__ __forceinline__ float wave_sum(float v) {
    v = row16_sum(v);
    const float t0 = __int_as_float(__builtin_amdgcn_readlane(__float_as_int(v), 0)), t1 = __int_as_float(__builtin_amdgcn_readlane(__float_as_int(v), 16)),
                t2 = __int_as_float(__builtin_amdgcn_readlane(__float_as_int(v), 32)), t3 = __int_as_float(__builtin_amdgcn_readlane(__float_as_int(v), 48));
    return (t0 + t1) + (t2 + t3);
}
__device__ __forceinline__ const float* xsrc_row(KP p, int layer, int r) {
    const int b = r / RB, i = r % RB;
    if (i < CTX) return (layer == 0 ? p->in[2] : (const float*)(p->ws + WS_XC)) + ((size_t)b * CTX + i) * D;
    return (layer == 0 ? p->in[0] : (const float*)p->out) + ((size_t)b * SEQ + (i - CTX)) * D;
}
__device__ __forceinline__ float* xdst_row(KP p, int r) {
    const int b = r / RB, i = r % RB;
    if (i < CTX) return (float*)(p->ws + WS_XC) + ((size_t)b * CTX + i) * D;
    return p->out + ((size_t)b * SEQ + (i - CTX)) * D;
}
__device__ __forceinline__ bf16_t* xb_row(KP p, int r) { const int b = r / RB, i = r % RB; return (bf16_t*)p->out + ((size_t)b * SEQ + (i - CTX)) * D; }
__device__ __forceinline__ bf16_t* x2_row(KP p, int layer, int r) { const int b = r / RB, i = r % RB; return (layer == 0 ? (bf16_t*)p->out : (bf16_t*)(p->ws + WS_HKV)) + ((size_t)b * SEQ + (i - CTX)) * D; }
__device__ __forceinline__ unsigned f8x4(float a, float b, float c, float d) { return (unsigned)__builtin_amdgcn_cvt_pk_fp8_f32(c, d, __builtin_amdgcn_cvt_pk_fp8_f32(a, b, 0, false), true); }
__device__ __forceinline__ float4 bf4(uint2 v) { return make_float4(__uint_as_float(v.x << 16), __uint_as_float(v.x & 0xFFFF0000u), __uint_as_float(v.y << 16), __uint_as_float(v.y & 0xFFFF0000u)); }
__device__ __forceinline__ unsigned char* kv_base(KP p, int layer) { return layer == 0 ? (unsigned char*)p->out : p->ws + WS_HKV; }
__device__ __forceinline__ const float* mod_vec(KP p, int layer, int r) {
    const int b = r / RB, i = r % RB;
    return (const float*)(p->ws + WS_MOD) + ((size_t)layer * 5 + (i < CTX ? 4 : b)) * 6144;
}

template <int BM, int BN, int WM, int WN>
struct GT {
    static constexpr int WTM = BM / WM, WTN = BN / WN, MT = WTM / 16, NTL = WTN / 16;
    static constexpr int AI = BM * 8 / NT, BI = BN * 8 / NT;
    static constexpr int ABYTES = BM * 128, BBYTES = BN * 128, STAGE = ABYTES + BBYTES;
};
__device__ __forceinline__ int st_row(int i) { return (i * NT + tidx()) >> 3; }
__device__ __forceinline__ int st_chunk(int i) { const int q = i * NT + tidx(); return (q & 7) ^ ((q >> 3) & 7); }

template <int BM, int BN, int WM, int WN, class SegF, class EpiF>
__device__ __forceinline__ void gemm_stream(SegF&& segf, EpiF&& epi, unsigned char* lds) {
    typedef GT<BM, BN, WM, WN> G;
    constexpr int NL = G::AI + G::BI;
    const int tid = tidx(), lane = tid & 63, wave = tid >> 6, wm = wave / WN, wn = wave % WN, fr = lane & 15, fq = lane >> 4;
    const int aoff = (wm * G::WTM + fr) * 128, boff = G::ABYTES + (wn * G::WTN + fr) * 128;
    const int sw0 = ((0 + fq) ^ (fr & 7)) << 4, sw1 = ((4 + fq) ^ (fr & 7)) << 4;
    const bf16_t* pa[G::AI]; const bf16_t* pb[G::BI]; long pstep = 0; int pnk = 0, ps = 0, pk = 0;
    if (!segf(0, pa, pstep, pb, pnk)) return;
    bool pvalid = true;
    int cs = 0, ck = 0, cnk = pnk, nk_next = 0, ibuf = 0, cbuf = 0, inflight = 0;
    f32x4 acc[G::MT][G::NTL] = {};
    auto issue = [&]() {
        unsigned char* dst = lds + ibuf * G::STAGE;
#pragma unroll
        for (int i = 0; i < G::AI; ++i) { __builtin_amdgcn_global_load_lds((const unsigned*)pa[i], (unsigned*)(dst + (i * NT + tid) * 16), 16, 0, 0); pa[i] += pstep; }
#pragma unroll
        for (int i = 0; i < G::BI; ++i) { __builtin_amdgcn_global_load_lds((const unsigned*)pb[i], (unsigned*)(dst + G::ABYTES + (i * NT + tid) * 16), 16, 0, 0); pb[i] += 64; }
        ibuf = ibuf == 2 ? 0 : ibuf + 1; ++inflight;
        if (++pk == pnk) { ++ps; pk = 0; int nk2 = 0; pvalid = segf(ps, pa, pstep, pb, nk2); pnk = nk2; nk_next = nk2; }
    };
    __syncthreads();
    issue(); if (pvalid) issue();
    for (;;) {
        if (inflight >= 2) asm volatile("s_waitcnt vmcnt(%0)" :: "n"(NL) : "memory"); else asm volatile("s_waitcnt vmcnt(0)" ::: "memory");
        __builtin_amdgcn_s_barrier();
        --inflight;
        if (pvalid) issue();
        const unsigned char* cur = lds + cbuf * G::STAGE; cbuf = cbuf == 2 ? 0 : cbuf + 1;
#pragma unroll
        for (int ks = 0; ks < 2; ++ks) {
            const int sw = ks ? sw1 : sw0;
            bf16x8 a[G::MT], b[G::NTL];
#pragma unroll
            for (int mt = 0; mt < G::MT; ++mt) a[mt] = *(const bf16x8*)(cur + aoff + mt * 2048 + sw);
#pragma unroll
            for (int nt = 0; nt < G::NTL; ++nt) b[nt] = *(const bf16x8*)(cur + boff + nt * 2048 + sw);
            __builtin_amdgcn_s_setprio(1);
#pragma unroll
            for (int mt = 0; mt < G::MT; ++mt)
#pragma unroll
                for (int nt = 0; nt < G::NTL; ++nt) acc[mt][nt] = __builtin_amdgcn_mfma_f32_16x16x32_bf16(b[nt], a[mt], acc[mt][nt], 0, 0, 0);
            __builtin_amdgcn_s_setprio(0);
        }
        if (++ck == cnk) { epi(cs, acc); ++cs; ck = 0; cnk = nk_next; if (inflight == 0 && !pvalid) break; }
    }
}
#define ZERO_ACC(acc, MT_, NTL_) do { _Pragma("unroll") for (int _m = 0; _m < (MT_); ++_m) _Pragma("unroll") for (int _n = 0; _n < (NTL_); ++_n) acc[_m][_n] = (f32x4){0.f, 0.f, 0.f, 0.f}; } while (0)

struct U256 { const char* A; const char* B; int K; int f8; const int* gidx; int gmax; int pB; int cont; };
__device__ __forceinline__ int g256_lds_byte(int r, int c) { const int st = (r >> 4) * 2 + (c >> 5), rr = r & 15, cc = c & 31, ob = rr * 64 + cc * 2; return st * 1024 + (ob ^ (((ob >> 9) & 1) << 5)); }
__device__ __forceinline__ void g256_stage_rc(int b, int& R, int& C) { const int st = b / 1024, sb = b % 1024, swz = sb ^ (((sb >> 9) & 1) << 5); R = (st >> 1) * 16 + swz / 64; C = (st & 1) * 32 + (swz % 64) / 2; }
__device__ __forceinline__ int g256_perm32(int rho) { const int n = rho >> 4, i = rho & 15; return 8 * (i >> 2) + 4 * n + (i & 3); }
template <bool PERM = false, class NextF, class EpiF>
__device__ __forceinline__ void gemm256(unsigned char* lds_g, NextF&& next, EpiF&& epi) {
    constexpr int HTB = 128 * 64 * 2;
    LAS unsigned char* lds = (LAS unsigned char*)lds_g;
    const int tid = tidx(), wid = __builtin_amdgcn_readfirstlane(tid >> 6), lane = tid & 63, wr = wid >> 2, wc = wid & 3, fr = lane & 15, fq = lane >> 4;
    int RR[2], CC[2], RB2[2];
#pragma unroll
    for (int i = 0; i < 2; ++i) { g256_stage_rc(tid * 16 + i * 8192, RR[i], CC[i]); RB2[i] = PERM ? ((RR[i] & ~31) + g256_perm32(RR[i] & 31)) : RR[i]; }
    const size_t kstep = 128;
    const unsigned ldsw = (unsigned)wid * 1024u;
    const int aoff = g256_lds_byte(wr * 64 + fr, fq * 8), boff = g256_lds_byte(wc * 32 + fr, fq * 8);
#define G2_SA(b, h) (((b) * 2 + (h)) * HTB)
#define G2_SB(b, h) ((4 + (b) * 2 + (h)) * HTB)
#define G2_STAGE(bufoff, gbase, voff) do { _Pragma("unroll") for (int _i = 0; _i < 2; ++_i) \
        __builtin_amdgcn_global_load_lds((const unsigned*)((const char*)(gbase) + (voff)[_i]), (LAS unsigned*)(lds + (bufoff) + ldsw + _i * 8192), 16, 0, 0); } while (0)
#define G2_LDA(dst, b, h) do { _Pragma("unroll") for (int m = 0; m < 4; ++m) _Pragma("unroll") for (int k = 0; k < 2; ++k) dst[m][k] = *(const LAS bf16x8*)(lds + G2_SA(b, h) + aoff + m * 2048 + k * 1024); } while (0)
#define G2_LDB(dst, b, h) do { _Pragma("unroll") for (int n = 0; n < 2; ++n) _Pragma("unroll") for (int k = 0; k < 2; ++k) dst[n][k] = *(const LAS bf16x8*)(lds + G2_SB(b, h) + boff + n * 2048 + k * 1024); } while (0)
#define G2_MMA(ai, bj, At, Bt) do { __builtin_amdgcn_s_setprio(1); _Pragma("unroll") for (int m = 0; m < 4; ++m) _Pragma("unroll") for (int n = 0; n < 2; ++n) _Pragma("unroll") for (int k = 0; k < 2; ++k) \
        acc[ai][bj][m][n] = __builtin_amdgcn_mfma_f32_16x16x32_bf16(Bt[n][k], At[m][k], acc[ai][bj][m][n], 0, 0, 0); __builtin_amdgcn_s_setprio(0); } while (0)
#define G2_WAIT_V(n) asm volatile("s_waitcnt vmcnt(" #n ")" ::: "memory")
#define G2_WAIT_L(n) asm volatile("s_waitcnt lgkmcnt(" #n ")" ::: "memory")
#define G2_BAR __builtin_amdgcn_s_barrier()
#define G2_SCHED __builtin_amdgcn_sched_barrier(0)
#define G2_ZERO() do { _Pragma("unroll") for (int a = 0; a < 2; ++a) _Pragma("unroll") for (int b = 0; b < 2; ++b) _Pragma("unroll") for (int m = 0; m < 4; ++m) _Pragma("unroll") for (int n = 0; n < 2; ++n) acc[a][b][m][n] = (f32x4){0.f, 0.f, 0.f, 0.f}; } while (0)
    U256 cur, nxt; int ui = 0;
    if (!next(0, cur)) return;
    __syncthreads();
    f32x4 acc[2][2][4][2];
    G2_ZERO();
    bf16x8 At[4][2], B0[2][2], B1[2][2];
    unsigned vo[2], nvo[2], vob[2], nvob[2];
#pragma unroll
    for (int i = 0; i < 2; ++i) { vo[i] = (unsigned)(RR[i] * cur.K + CC[i]) * 2u; vob[i] = (unsigned)(RB2[i] * cur.K + CC[i]) * 2u; }
    size_t hstep = (size_t)128 * cur.K * 2;
    const char* cA = cur.A; const char* cB = cur.B;
    G2_STAGE(G2_SB(0, 0), cB, vob); G2_STAGE(G2_SA(0, 0), cA, vo); G2_STAGE(G2_SB(0, 1), cB + hstep, vob); G2_STAGE(G2_SA(0, 1), cA + hstep, vo);
    if (wr == 1) G2_BAR;
    G2_WAIT_V(4); G2_BAR;
    G2_STAGE(G2_SB(1, 0), cB + kstep, vob); G2_STAGE(G2_SA(1, 0), cA + kstep, vo); G2_STAGE(G2_SB(1, 1), cB + hstep + kstep, vob);
    G2_WAIT_V(6); G2_BAR;
    for (;;) {
        const bool has_next = next(ui + 1, nxt);
        const char* nA = has_next ? nxt.A : cA; const char* nB = has_next ? nxt.B : cB; const int nK = has_next ? nxt.K : cur.K;
#pragma unroll
        for (int i = 0; i < 2; ++i) { nvo[i] = (unsigned)(RR[i] * nK + CC[i]) * 2u; nvob[i] = (unsigned)(RB2[i] * nK + CC[i]) * 2u; }
        const size_t nh = (size_t)128 * nK * 2;
        const int nt = cur.K >> 6;
        for (int t = 0; t < nt; t += 2) {
            const bool last = (t == nt - 2);
            const char* a1 = cA + (size_t)(t + 1) * kstep;
            const char* a2 = last ? nA : cA + (size_t)(t + 2) * kstep; const char* b2 = last ? nB : cB + (size_t)(t + 2) * kstep;
            const char* a3 = a2 + kstep; const char* b3 = b2 + kstep;
            unsigned v2[2], v2b[2]; v2[0] = last ? nvo[0] : vo[0]; v2[1] = last ? nvo[1] : vo[1]; v2b[0] = last ? nvob[0] : vob[0]; v2b[1] = last ? nvob[1] : vob[1];
            const size_t h2 = last ? nh : hstep;
            G2_LDB(B0, 0, 0); G2_SCHED; G2_LDA(At, 0, 0); G2_STAGE(G2_SA(1, 1), a1 + hstep, vo);
            G2_WAIT_L(8); G2_BAR; G2_WAIT_L(0); G2_MMA(0, 0, At, B0); G2_BAR; G2_SCHED;
            G2_LDB(B1, 0, 1); G2_STAGE(G2_SB(0, 0), b2, v2b);
            G2_BAR; G2_WAIT_L(0); G2_MMA(0, 1, At, B1); G2_BAR;
            G2_LDA(At, 0, 1); G2_STAGE(G2_SA(0, 0), a2, v2);
            G2_BAR; G2_WAIT_L(0); G2_MMA(1, 0, At, B0); G2_BAR; G2_SCHED;
            G2_STAGE(G2_SB(0, 1), b2 + h2, v2b);
            G2_WAIT_V(6); G2_BAR; G2_MMA(1, 1, At, B1); G2_BAR;
            G2_LDB(B0, 1, 0); G2_SCHED; G2_LDA(At, 1, 0); G2_STAGE(G2_SA(0, 1), a2 + h2, v2);
            G2_WAIT_L(8); G2_BAR; G2_WAIT_L(0); G2_MMA(0, 0, At, B0); G2_BAR; G2_SCHED;
            G2_LDB(B1, 1, 1); G2_STAGE(G2_SB(1, 0), b3, v2b);
            G2_BAR; G2_WAIT_L(0); G2_MMA(0, 1, At, B1); G2_BAR;
            G2_LDA(At, 1, 1); G2_STAGE(G2_SA(1, 0), a3, v2);
            G2_BAR; G2_WAIT_L(0); G2_MMA(1, 0, At, B0); G2_BAR; G2_SCHED;
            G2_STAGE(G2_SB(1, 1), b3 + h2, v2b);
            G2_WAIT_V(6); G2_BAR; G2_MMA(1, 1, At, B1); G2_BAR;
        }
        epi(ui, acc, wr, wc, fr, fq);
        if (!has_next) break;
        G2_ZERO();
        cur = nxt; cA = nA; cB = nB; vo[0] = nvo[0]; vo[1] = nvo[1]; vob[0] = nvob[0]; vob[1] = nvob[1]; hstep = nh; ++ui;
    }
    G2_WAIT_V(0);
    if (wr == 0) G2_BAR;
    G2_BAR;
#undef G2_SA
#undef G2_SB
#undef G2_STAGE
#undef G2_LDA
#undef G2_LDB
#undef G2_MMA
#undef G2_WAIT_V
#undef G2_WAIT_L
#undef G2_BAR
#undef G2_SCHED
#undef G2_ZERO
}
template <class NextF, class EpiF>
__device__ __forceinline__ void gemm256h3(unsigned char* lds_g, NextF&& next, EpiF&& epi) {
    constexpr unsigned HTB = 128 * 64 * 2, BUFB = 3 * HTB;
    LAS unsigned char* lds = (LAS unsigned char*)lds_g;
    const int tid = tidx(), wid = __builtin_amdgcn_readfirstlane(tid >> 6), lane = tid & 63, wr = wid >> 2, wc = wid & 3, fr = lane & 15, fq = lane >> 4;
    int RR[2], CC[2];
#pragma unroll
    for (int i = 0; i < 2; ++i) g256_stage_rc(tid * 16 + i * 8192, RR[i], CC[i]);
    const size_t kstep = 128;
    const unsigned ldsw = (unsigned)wid * 1024u;
    const unsigned aoff = g256_lds_byte(wr * 64 + fr, fq * 8), boff = g256_lds_byte(wc * 32 + fr, fq * 8) + 2 * HTB;
#define H3_STAGE(bufoff, gbase, voff) do { _Pragma("unroll") for (int _i = 0; _i < 2; ++_i) \
        __builtin_amdgcn_global_load_lds((const unsigned*)((const char*)(gbase) + (voff)[_i]), (LAS unsigned*)(lds + (bufoff) + ldsw + _i * 8192), 16, 0, 0); } while (0)
#define H3_LDA(dst, bo, h) do { _Pragma("unroll") for (int m = 0; m < 4; ++m) _Pragma("unroll") for (int k = 0; k < 2; ++k) dst[m][k] = *(const LAS bf16x8*)(lds + (bo) + aoff + (h) * HTB + m * 2048 + k * 1024); } while (0)
#define H3_LDB(dst, bo) do { _Pragma("unroll") for (int n = 0; n < 2; ++n) _Pragma("unroll") for (int k = 0; k < 2; ++k) dst[n][k] = *(const LAS bf16x8*)(lds + (bo) + boff + n * 2048 + k * 1024); } while (0)
#define H3_MMA(ai, At, Bt) do { __builtin_amdgcn_s_setprio(1); _Pragma("unroll") for (int m = 0; m < 4; ++m) _Pragma("unroll") for (int n = 0; n < 2; ++n) _Pragma("unroll") for (int k = 0; k < 2; ++k) \
        acc[ai][m][n] = __builtin_amdgcn_mfma_f32_16x16x32_bf16(Bt[n][k], At[m][k], acc[ai][m][n], 0, 0, 0); __builtin_amdgcn_s_setprio(0); } while (0)
#define H3_MMA8(ai, At, Bt) do { __builtin_amdgcn_s_setprio(1); _Pragma("unroll") for (int m = 0; m < 4; ++m) _Pragma("unroll") for (int n = 0; n < 2; ++n) { \
        const i32x4 a0 = __builtin_bit_cast(i32x4, At[m][0]), a1 = __builtin_bit_cast(i32x4, At[m][1]), b0 = __builtin_bit_cast(i32x4, Bt[n][0]), b1 = __builtin_bit_cast(i32x4, Bt[n][1]); \
        const i32x8 av = __builtin_shufflevector(a0, a1, 0, 1, 2, 3, 4, 5, 6, 7), bv = __builtin_shufflevector(b0, b1, 0, 1, 2, 3, 4, 5, 6, 7); \
        acc[ai][m][n] = __builtin_amdgcn_mfma_scale_f32_16x16x128_f8f6f4(bv, av, acc[ai][m][n], 0, 0, 0, 0x7F7F7F7F, 0, 0x7F7F7F7F); } __builtin_amdgcn_s_setprio(0); } while (0)
#define H3_WAIT_V(n) asm volatile("s_waitcnt vmcnt(" #n ")" ::: "memory")
#define H3_WAIT_L(n) asm volatile("s_waitcnt lgkmcnt(" #n ")" ::: "memory")
#define H3_BAR __builtin_amdgcn_s_barrier()
#define H3_SCHED __builtin_amdgcn_sched_barrier(0)
#define H3_ZERO() do { _Pragma("unroll") for (int a = 0; a < 2; ++a) _Pragma("unroll") for (int m = 0; m < 4; ++m) _Pragma("unroll") for (int n = 0; n < 2; ++n) acc[a][m][n] = (f32x4){0.f, 0.f, 0.f, 0.f}; } while (0)
#define H3_KLOOP(MMA_) \
        for (int t = 0; t < nt; ++t) { \
            const int t2 = t + 2; const bool wrap = t2 >= nt; \
            const char* sa = wrap ? nA + (size_t)(t2 - nt) * kstep : cA + (size_t)t2 * kstep; \
            const char* sb = wrap ? nB + (size_t)(t2 - nt) * kstep : cB + (size_t)t2 * kstep; \
            unsigned sv[2]; sv[0] = wrap ? nvo[0] : vo[0]; sv[1] = wrap ? nvo[1] : vo[1]; \
            const size_t sh = wrap ? nh : hstep; \
            H3_LDB(B0, bc); H3_SCHED; H3_LDA(At, bc, 0); H3_STAGE(bp + 2 * HTB, sb, sv); H3_STAGE(bp, sa, sv); \
            H3_WAIT_V(10); H3_BAR; H3_WAIT_L(0); MMA_(0, At, B0); H3_BAR; H3_SCHED; \
            H3_LDA(At, bc, 1); H3_STAGE(bp + HTB, sa + sh, sv); \
            H3_WAIT_V(8); H3_BAR; H3_WAIT_L(0); MMA_(1, At, B0); H3_BAR; H3_SCHED; \
            const unsigned tb = bc; bc = bn; bn = bp; bp = tb; \
        }
    U256 cur, nxt; int ui = 0;
    if (!next(0, cur)) return;
    __syncthreads();
    f32x4 acc[2][4][2];
    H3_ZERO();
    bf16x8 At[4][2], B0[2][2];
    unsigned vo[2], nvo[2];
#pragma unroll
    for (int i = 0; i < 2; ++i) vo[i] = (unsigned)(RR[i] * cur.K + CC[i]) * 2u;
    size_t hstep = (size_t)128 * cur.K * 2;
    const char* cA = cur.A; const char* cB = cur.B;
    unsigned bc = 0, bn = BUFB, bp = 2 * BUFB;
    H3_STAGE(bc + 2 * HTB, cB, vo); H3_STAGE(bc, cA, vo); H3_STAGE(bc + HTB, cA + hstep, vo);
    H3_STAGE(bn + 2 * HTB, cB + kstep, vo); H3_STAGE(bn, cA + kstep, vo); H3_STAGE(bn + HTB, cA + hstep + kstep, vo);
    if (wr == 1) H3_BAR;
    H3_WAIT_V(8); H3_BAR;
    H3_BAR;
    for (;;) {
        const bool has_next = next(ui + 1, nxt);
        const char* nA = has_next ? nxt.A : cA; const char* nB = has_next ? nxt.B : cB; const int nK = has_next ? nxt.K : cur.K;
#pragma unroll
        for (int i = 0; i < 2; ++i) nvo[i] = (unsigned)(RR[i] * nK + CC[i]) * 2u;
        const size_t nh = (size_t)128 * nK * 2;
        const int nt = cur.K >> 6; const bool f8 = cur.f8 != 0;
        if (f8) { H3_KLOOP(H3_MMA8) } else { H3_KLOOP(H3_MMA) }
        epi(ui, acc, wr, wc, fr, fq);
        if (!has_next) break;
        H3_ZERO();
        cur = nxt; cA = nA; cB = nB; vo[0] = nvo[0]; vo[1] = nvo[1]; hstep = nh; ++ui;
    }
    H3_WAIT_V(0);
    if (wr == 0) H3_BAR;
    H3_BAR;
#undef H3_STAGE
#undef H3_LDA
#undef H3_LDB
#undef H3_MMA
#undef H3_MMA8
#undef H3_KLOOP
#undef H3_WAIT_V
#undef H3_WAIT_L
#undef H3_BAR
#undef H3_SCHED
#undef H3_ZERO
}
template <class NextF, class EpiF>
__device__ __forceinline__ void gemm256h3g(unsigned char* lds_g, NextF&& next, EpiF&& epi) {
    constexpr unsigned HTB = 128 * 64 * 2, BUFB = 3 * HTB;
    LAS unsigned char* lds = (LAS unsigned char*)lds_g;
    const int tid = tidx(), wid = __builtin_amdgcn_readfirstlane(tid >> 6), lane = tid & 63, wr = wid >> 2, wc = wid & 3, fr = lane & 15, fq = lane >> 4;
    int RR[2], CC[2];
#pragma unroll
    for (int i = 0; i < 2; ++i) g256_stage_rc(tid * 16 + i * 8192, RR[i], CC[i]);
    const size_t kstep = 128;
    const unsigned ldsw = (unsigned)wid * 1024u;
    const unsigned aoff = g256_lds_byte(wr * 64 + fr, fq * 8), boff = g256_lds_byte(wc * 32 + fr, fq * 8) + 2 * HTB;
#define H3_STAGE(bufoff, gbase, voff) do { _Pragma("unroll") for (int _i = 0; _i < 2; ++_i) \
        __builtin_amdgcn_global_load_lds((const unsigned*)((const char*)(gbase) + (voff)[_i]), (LAS unsigned*)(lds + (bufoff) + ldsw + _i * 8192), 16, 0, 0); } while (0)
#define H3_LDA(dst, bo, h) do { _Pragma("unroll") for (int m = 0; m < 4; ++m) _Pragma("unroll") for (int k = 0; k < 2; ++k) dst[m][k] = *(const LAS bf16x8*)(lds + (bo) + aoff + (h) * HTB + m * 2048 + k * 1024); } while (0)
#define H3_LDB(dst, bo) do { _Pragma("unroll") for (int n = 0; n < 2; ++n) _Pragma("unroll") for (int k = 0; k < 2; ++k) dst[n][k] = *(const LAS bf16x8*)(lds + (bo) + boff + n * 2048 + k * 1024); } while (0)
#define H3_MMA(ai, At, Bt) do { __builtin_amdgcn_s_setprio(1); _Pragma("unroll") for (int m = 0; m < 4; ++m) _Pragma("unroll") for (int n = 0; n < 2; ++n) { \
        const i32x4 a0 = __builtin_bit_cast(i32x4, At[m][0]), a1 = __builtin_bit_cast(i32x4, At[m][1]), b0 = __builtin_bit_cast(i32x4, Bt[n][0]), b1 = __builtin_bit_cast(i32x4, Bt[n][1]); \
        const i32x8 av = __builtin_shufflevector(a0, a1, 0, 1, 2, 3, 4, 5, 6, 7), bv = __builtin_shufflevector(b0, b1, 0, 1, 2, 3, 4, 5, 6, 7); \
        acc[ai][m][n] = __builtin_amdgcn_mfma_scale_f32_16x16x128_f8f6f4(av, bv, acc[ai][m][n], 0, 0, 0, 0x7F7F7F7F, 0, 0x7F7F7F7F); } __builtin_amdgcn_s_setprio(0); } while (0)
#define H3_WAIT_V(n) asm volatile("s_waitcnt vmcnt(" #n ")" ::: "memory")
#define H3_WAIT_L(n) asm volatile("s_waitcnt lgkmcnt(" #n ")" ::: "memory")
#define H3_BAR __builtin_amdgcn_s_barrier()
#define H3_SCHED __builtin_amdgcn_sched_barrier(0)
#define H3_ZERO() do { _Pragma("unroll") for (int a = 0; a < 2; ++a) _Pragma("unroll") for (int m = 0; m < 4; ++m) _Pragma("unroll") for (int n = 0; n < 2; ++n) acc[a][m][n] = (f32x4){0.f, 0.f, 0.f, 0.f}; } while (0)
#define H3_KLOOP(MMA_) \
        _Pragma("unroll 1") for (int t = 0; t < nt; ++t) { \
            if (t == 2 && ngather) { _Pragma("unroll") for (int i = 0; i < 2; ++i) nvob[i] = (unsigned)(gix[((ui + 1) % 3) * 128 + RR[i]] * npB + CC[i]) * 2u; } \
            const int t2 = t + 2; const bool wrap = t2 >= nt; \
            const char* sa = wrap ? nA + (size_t)(t2 - nt) * kstep : cA + (size_t)t2 * kstep; \
            const char* sb = wrap ? nB + (size_t)(t2 - nt) * kstep : cB + (size_t)t2 * kstep; \
            unsigned sv[2], svb[2]; sv[0] = wrap ? nvo[0] : vo[0]; sv[1] = wrap ? nvo[1] : vo[1]; svb[0] = wrap ? nvob[0] : vob[0]; svb[1] = wrap ? nvob[1] : vob[1]; \
            const size_t sh = wrap ? nh : hstep; \
            H3_LDB(B0, bc); H3_SCHED; H3_LDA(At, bc, 0); H3_STAGE(bp + 2 * HTB, sb, svb); H3_STAGE(bp, sa, sv); \
            H3_WAIT_V(10); H3_BAR; H3_WAIT_L(0); MMA_(0, At, B0); H3_BAR; H3_SCHED; \
            H3_LDA(At, bc, 1); H3_STAGE(bp + HTB, sa + sh, sv); \
            H3_WAIT_V(8); H3_BAR; H3_WAIT_L(0); MMA_(1, At, B0); H3_BAR; H3_SCHED; \
            const unsigned tb = bc; bc = bn; bn = bp; bp = tb; \
        }
    U256 cur, nxt; int ui = 0;
    if (!next(0, cur)) return;
    __syncthreads();
    f32x4 acc[2][4][2];
    H3_ZERO();
    bf16x8 At[4][2], B0[2][2];
    unsigned vo[2], nvo[2], vob[2], nvob[2] = {0u, 0u};
    LAS int* gix = (LAS int*)(lds + 149504);
#pragma unroll
    for (int i = 0; i < 2; ++i) { vo[i] = (unsigned)(RR[i] * cur.K + CC[i]) * 2u; const int r = RR[i] < cur.gmax ? RR[i] : cur.gmax - 1; const int gr = cur.gidx ? cur.gidx[r] : RR[i];
        vob[i] = (unsigned)(gr * cur.pB + CC[i]) * 2u; if (CC[i] == 0) gix[RR[i]] = gr; }
    size_t hstep = (size_t)128 * cur.K * 2;
    const char* cA = cur.A; const char* cB = cur.B;
    unsigned bc = 0, bn = BUFB, bp = 2 * BUFB;
    H3_STAGE(bc + 2 * HTB, cB, vob); H3_STAGE(bc, cA, vo); H3_STAGE(bc + HTB, cA + hstep, vo);
    H3_STAGE(bn + 2 * HTB, cB + kstep, vob); H3_STAGE(bn, cA + kstep, vo); H3_STAGE(bn + HTB, cA + hstep + kstep, vo);
    if (wr == 1) H3_BAR;
    H3_WAIT_V(8); H3_BAR;
    H3_BAR;
    for (;;) {
        const bool has_next = next(ui + 1, nxt);
        const char* nA = has_next ? nxt.A : cA; const char* nB = has_next ? nxt.B : cB; const int nK = has_next ? nxt.K : cur.K;
#pragma unroll
        for (int i = 0; i < 2; ++i) nvo[i] = (unsigned)(RR[i] * nK + CC[i]) * 2u;
        const size_t nh = (size_t)128 * nK * 2;
        int nt = cur.K >> 6; asm volatile("" : "+s"(nt));
        const int* ngidx = has_next ? nxt.gidx : cur.gidx; const bool ngather = ngidx != nullptr; const int npB = has_next ? nxt.pB : cur.pB;
        if (!ngather) { _Pragma("unroll") for (int i = 0; i < 2; ++i) nvob[i] = (unsigned)(RR[i] * npB + CC[i]) * 2u; }
        if (wid < 2 && ngather) { const int gm = has_next ? nxt.gmax : cur.gmax, li = wid * 64 + lane; const int* gsrc = ngidx + (li < gm ? li : gm - 1);
            __builtin_amdgcn_global_load_lds((const unsigned*)gsrc, (LAS unsigned*)(lds + 149504 + ((ui + 1) % 3) * 512 + wid * 256), 4, 0, 0); }
        H3_KLOOP(H3_MMA)
        if (!cur.cont) epi(ui, acc, wr, wc, fr, fq, (const LAS int*)(gix + (ui % 3) * 128));
        if (!has_next) break;
        if (!cur.cont) H3_ZERO();
        cur = nxt; cA = nA; cB = nB; vo[0] = nvo[0]; vo[1] = nvo[1]; vob[0] = nvob[0]; vob[1] = nvob[1]; hstep = nh; ++ui;
    }
    H3_WAIT_V(0);
    if (wr == 0) H3_BAR;
    H3_BAR;
#undef H3_STAGE
#undef H3_LDA
#undef H3_LDB
#undef H3_MMA
#undef H3_KLOOP
#undef H3_WAIT_V
#undef H3_WAIT_L
#undef H3_BAR
#undef H3_SCHED
#undef H3_ZERO
}

template <int NTL, int KS>
__device__ __forceinline__ void wave_mma(f32x4 (&acc)[NTL], const unsigned char* a, int lda, const unsigned char* b, int ldb) {
    const int lane = tidx() & 63, fr = lane & 15, fq = lane >> 4;
#pragma unroll
    for (int ks = 0; ks < KS; ++ks) {
        const bf16x8 af = *(const bf16x8*)(a + fr * lda + ks * 64 + fq * 16);
#pragma unroll
        for (int nt = 0; nt < NTL; ++nt) {
            const bf16x8 bf = *(const bf16x8*)(b + (nt * 16 + fr) * ldb + ks * 64 + fq * 16);
            acc[nt] = __builtin_amdgcn_mfma_f32_16x16x32_bf16(af, bf, acc[nt], 0, 0, 0);
        }
    }
}

template <int NTL, int KS>
__device__ __forceinline__ void wave_mma_t(f32x4 (&acc)[NTL], const unsigned char* a, int lda, const unsigned char* b, int ldb) {
    const int lane = tidx() & 63, fr = lane & 15, fq = lane >> 4;
#pragma unroll
    for (int ks = 0; ks < KS; ++ks) {
        const bf16x8 af = *(const bf16x8*)(a + fr * lda + ks * 64 + fq * 16);
#pragma unroll
        for (int nt = 0; nt < NTL; ++nt) {
            const bf16x8 bf = *(const bf16x8*)(b + (nt * 16 + fr) * ldb + ks * 64 + fq * 16);
            acc[nt] = __builtin_amdgcn_mfma_f32_16x16x32_bf16(bf, af, acc[nt], 0, 0, 0);
        }
    }
}

__device__ __forceinline__ void unit_mod(KP p, int u) {
    const int l = u / 96, j0 = (u % 96) * 64, tid = tidx();
    float* act = (float*)smem;
    float* red = act + 5 * 1024;
    __syncthreads();
    for (int i = tid; i < 5 * 1024; i += NT) { const int v = i >> 10, k = i & 1023; const float c = v < 4 ? p->in[1][v * 1024 + k] : p->in[3][k]; act[i] = c / (1.f + expf(-c)); }
    __syncthreads();
    const int col = tid & 63, ks = tid >> 6;
    const float* w = p->in[6] + (size_t)l * 1024 * 6144 + j0 + col;
    float a0 = 0, a1 = 0, a2 = 0, a3 = 0, a4 = 0;
#pragma unroll 16
    for (int k = ks * 128; k < ks * 128 + 128; ++k) { const float wv = w[(size_t)k * 6144]; a0 += act[k] * wv; a1 += act[1024 + k] * wv; a2 += act[2048 + k] * wv; a3 += act[3072 + k] * wv; a4 += act[4096 + k] * wv; }
    red[(ks * 5 + 0) * 64 + col] = a0; red[(ks * 5 + 1) * 64 + col] = a1; red[(ks * 5 + 2) * 64 + col] = a2; red[(ks * 5 + 3) * 64 + col] = a3; red[(ks * 5 + 4) * 64 + col] = a4;
    __syncthreads();
    if (tid < 320) { const int v = tid >> 6, c = tid & 63; float s = 0.f;
        for (int k = 0; k < 8; ++k) s += red[(k * 5 + v) * 64 + c];
        ((float*)(p->ws + WS_MOD))[((size_t)l * 5 + v) * 6144 + j0 + c] = s + p->in[7][l * 6144 + j0 + c]; }
}
__device__ __forceinline__ void unit_tables(KP p, int u) {
    const int tid = tidx();
    if (u == 0) {
        bf16_t* gw = (bf16_t*)(p->ws + WS_GWB);
#pragma unroll 6
        for (int i = tid; i < 2 * 4 * 128 * 40; i += NT) { const int k = i % 40, n = (i / 40) & 127, hh = (i / 5120) & 3, l = i / 20480, d = n >> 6, dk = n & 63;
            gw[i] = (k < 32 && (k >> 4) == d) ? (bf16_t)f2bf(p->in[22][(((size_t)l * 2 + d) * 16 + (k & 15)) * 256 + hh * 64 + dk]) : (bf16_t)0; }
        float* t = (float*)(p->ws + WS_ROPE);
#pragma unroll 6
        for (int i = tid; i < 192 * 16; i += NT) {
            const int pos = i >> 4, f = i & 15; const double inv = (double)exp2f(-(float)f * (13.287712379549449f / 16.f));
            const double rev = (double)(pos < 128 ? pos : pos - 128) * inv * 0.15915494309189535;
            const float fr = (float)(rev - rint(rev)); const float c = __builtin_amdgcn_cosf(fr), s = __builtin_amdgcn_sinf(fr);
            if (pos < 128) { t[pos * 16 + f] = c; t[2048 + pos * 16 + f] = s; } else { t[4096 + (pos - 128) * 16 + f] = c; t[4096 + 1024 + (pos - 128) * 16 + f] = s; }
        }
    } else {
        const int l = (u - 1) / 4, part = (u - 1) % 4;
        float* wr = (float*)(p->ws + WS_WR) + (size_t)l * 36 * 1024;
#pragma unroll 6
        for (int i = part * 9216 + tid; i < part * 9216 + 9216; i += NT) { const int o = i >> 10, k = i & 1023;
            wr[i] = o < 4 ? p->in[33][((size_t)l * 1024 + k) * 4 + o] : p->in[35][((size_t)l * 1024 + k) * 32 + (o - 4)]; }
    }
}
__device__ __forceinline__ void unit_s5w(KP p, int u) {
    const int l = u >> 4, g = u & 15, tid = tidx();
    float2* pw = (float2*)smem;
    float2* bb = pw + 2 * 17 * 64;
    float2* cc = bb + 2 * 64 * 16;
    float* mt = (float*)(cc + 2 * 16 * 65 + 32);
    __syncthreads();
    const int pi0 = tid & 63; const size_t gi0 = ((size_t)l * 2 + 0) * 16 + g, gi1 = ((size_t)l * 2 + 1) * 16 + g;
    const float lr0 = p->in[11][gi0 * 64 + pi0], li0 = p->in[12][gi0 * 64 + pi0], lr1 = p->in[11][gi1 * 64 + pi0], li1 = p->in[12][gi1 * 64 + pi0];
    const float ldt0 = p->in[13][gi0], ldt1 = p->in[13][gi1], dskv = p->in[18][l * 256 + g * 16 + (tid & 15)];
    const double dt0 = exp((double)ldt0), dt1 = exp((double)ldt1);
    for (int i = tid; i < 2 * 17 * 64; i += NT) {
        const int d = i / (17 * 64), t = (i >> 6) % 17, pi = pi0; const size_t gi = d ? gi1 : gi0;
        const float lr = d ? lr1 : lr0, li = d ? li1 : li0; const double dt = d ? dt1 : dt0;
        const double rev = (double)li * dt * t * 0.15915494309189535; const float fr = (float)(rev - rint(rev));
        const float mg = expf((float)((double)lr * dt * t)); const float2 a = make_float2(mg * __builtin_amdgcn_cosf(fr), mg * __builtin_amdgcn_sinf(fr));
        pw[i] = a;
        if (t == 16) ((float2*)(p->ws + WS_A16))[gi * 64 + pi] = a;
    }
    float2* crci = (float2*)(mt + 2 * 16 * 16 * 16);
    float* dsk = (float*)(crci + 128);
    if (tid < 16) dsk[tid] = dskv;
    if (tid < 128) {
        const int d = tid >> 6;
        const double lr = d ? lr1 : lr0, li = d ? li1 : li0, dt = d ? dt1 : dt0;
        const double mg = exp(lr * dt), ar = mg * cos(li * dt), ai = mg * sin(li * dt), den = lr * lr + li * li, nr = ar - 1.0, ni = ai;
        crci[tid] = make_float2((float)((nr * lr + ni * li) / den), (float)((ni * lr - nr * li) / den));
    }
    __syncthreads();
    for (int i = tid; i < 2 * 64 * 16; i += NT) {
        const int d = i >> 10, pi = (i >> 4) & 63, h = i & 15; const size_t gi = (((size_t)l * 2 + d) * 16 + g);
        const float2 c = crci[d * 64 + pi];
        const float br = p->in[14][(gi * 64 + pi) * 16 + h], bi = p->in[15][(gi * 64 + pi) * 16 + h];
        bb[i] = make_float2(c.x * br - c.y * bi, c.x * bi + c.y * br);
    }
    for (int i = tid; i < 2 * 16 * 64; i += NT) { const int d = i >> 10, h = (i >> 6) & 15, pi = i & 63; const size_t gi = (((size_t)l * 2 + d) * 16 + g);
        cc[(d * 16 + h) * 65 + pi] = make_float2(p->in[16][(gi * 16 + h) * 64 + pi], p->in[17][(gi * 16 + h) * 64 + pi]); }
    __syncthreads();
    {
        const int d = tid >> 8, tau = (tid >> 4) & 15, h = tid & 15;
        float s0 = 0.f, s1 = 0.f, s2 = 0.f, s3 = 0.f, s4 = 0.f, s5 = 0.f, s6 = 0.f, s7 = 0.f, s8 = 0.f, s9 = 0.f, s10 = 0.f, s11 = 0.f, s12 = 0.f, s13 = 0.f, s14 = 0.f, s15 = 0.f;
#pragma unroll 2
        for (int pi = 0; pi < 64; ++pi) { const float2 c = cc[(d * 16 + h) * 65 + pi], a = pw[(d * 17 + tau) * 64 + pi];
            const float xr = c.x * a.x - c.y * a.y, xi = c.x * a.y + c.y * a.x;
            const float4* b4 = (const float4*)(bb + (d * 64 + pi) * 16);
            float4 b;
            b = b4[0]; s0 += xr * b.x - xi * b.y; s1 += xr * b.z - xi * b.w;
            b = b4[1]; s2 += xr * b.x - xi * b.y; s3 += xr * b.z - xi * b.w;
            b = b4[2]; s4 += xr * b.x - xi * b.y; s5 += xr * b.z - xi * b.w;
            b = b4[3]; s6 += xr * b.x - xi * b.y; s7 += xr * b.z - xi * b.w;
            b = b4[4]; s8 += xr * b.x - xi * b.y; s9 += xr * b.z - xi * b.w;
            b = b4[5]; s10 += xr * b.x - xi * b.y; s11 += xr * b.z - xi * b.w;
            b = b4[6]; s12 += xr * b.x - xi * b.y; s13 += xr * b.z - xi * b.w;
            b = b4[7]; s14 += xr * b.x - xi * b.y; s15 += xr * b.z - xi * b.w; }
        float4* mo = (float4*)(mt + tid * 16);
        mo[0] = make_float4(s0, s1, s2, s3); mo[1] = make_float4(s4, s5, s6, s7); mo[2] = make_float4(s8, s9, s10, s11); mo[3] = make_float4(s12, s13, s14, s15);
    }
    __syncthreads();
    bf16_t* w1 = (bf16_t*)(p->ws + WS_S5W1) + (size_t)u * 512 * 256;
    bf16_t* w2 = (bf16_t*)(p->ws + WS_S5W2) + (size_t)u * 256 * 256;
    for (int q = tid; q < 8192; q += NT) {
        const int h = q & 15, kg = (q >> 4) & 31, s = q >> 9, n = s * 16 + h, k0 = kg * 8, s2 = kg >> 1, hb = (kg & 1) * 8;
        const int t0 = s2 <= s ? s - s2 : 0, t1 = s2 >= s ? s2 - s : 0; const float f0 = s2 <= s ? 1.f : 0.f, f1 = s2 >= s ? 1.f : 0.f;
        const float4* m0 = (const float4*)(mt + (t0 * 16 + h) * 16 + hb); const float4* m1 = (const float4*)(mt + ((16 + t1) * 16 + h) * 16 + hb);
        const float4 x0 = m0[0], y0 = m0[1], x1 = m1[0], y1 = m1[1]; const int e = n - k0; const float dv = dsk[h];
        const float v0 = f0 * x0.x + f1 * x1.x + (e == 0 ? dv : 0.f), v1 = f0 * x0.y + f1 * x1.y + (e == 1 ? dv : 0.f), v2 = f0 * x0.z + f1 * x1.z + (e == 2 ? dv : 0.f), v3 = f0 * x0.w + f1 * x1.w + (e == 3 ? dv : 0.f);
        const float v4 = f0 * y0.x + f1 * y1.x + (e == 4 ? dv : 0.f), v5 = f0 * y0.y + f1 * y1.y + (e == 5 ? dv : 0.f), v6 = f0 * y0.z + f1 * y1.z + (e == 6 ? dv : 0.f), v7 = f0 * y0.w + f1 * y1.w + (e == 7 ? dv : 0.f);
        const u32x4 o = {pk2(v0, v1), pk2(v2, v3), pk2(v4, v5), pk2(v6, v7)};
        *(u32x4*)(w1 + n * 256 + k0) = o;
    }
    for (int q = tid; q < 8192; q += NT) {
        const int n = q >> 5, k0 = (q & 31) * 8, d = n >> 7, part = (n >> 6) & 1, pi = n & 63, s2 = k0 >> 4, hb = k0 & 15, e = d == 0 ? 15 - s2 : s2;
        const float2 a = pw[(d * 17 + e) * 64 + pi]; const float4* b4 = (const float4*)(bb + (d * 64 + pi) * 16 + hb);
        const float4 b0 = b4[0], b1 = b4[1], b2 = b4[2], b3 = b4[3];
#define S5W1V(x_, y_) (part == 0 ? a.x * (x_) - a.y * (y_) : a.x * (y_) + a.y * (x_))
        const u32x4 o = {pk2(S5W1V(b0.x, b0.y), S5W1V(b0.z, b0.w)), pk2(S5W1V(b1.x, b1.y), S5W1V(b1.z, b1.w)), pk2(S5W1V(b2.x, b2.y), S5W1V(b2.z, b2.w)), pk2(S5W1V(b3.x, b3.y), S5W1V(b3.z, b3.w))};
#undef S5W1V
        *(u32x4*)(w1 + 256 * 256 + n * 256 + k0) = o;
    }
    for (int q = tid; q < 8192; q += NT) {
        const int n = q >> 5, k0 = (q & 31) * 8, s = n >> 4, h = n & 15, d = k0 >> 7, part = (k0 >> 6) & 1, pi0 = k0 & 63, e = d == 0 ? s + 1 : 16 - s;
        const float2* cp = cc + (d * 16 + h) * 65 + pi0; const float4* a4 = (const float4*)(pw + (d * 17 + e) * 64 + pi0);
        const float4 a0 = a4[0], a1 = a4[1], a2 = a4[2], a3 = a4[3];
        const float2 c0 = cp[0], c1 = cp[1], c2 = cp[2], c3 = cp[3], c4 = cp[4], c5 = cp[5], c6 = cp[6], c7 = cp[7];
#define S5W2V(c_, x_, y_) (part == 0 ? c_.x * (x_) - c_.y * (y_) : -(c_.x * (y_) + c_.y * (x_)))
        const u32x4 o = {pk2(S5W2V(c0, a0.x, a0.y), S5W2V(c1, a0.z, a0.w)), pk2(S5W2V(c2, a1.x, a1.y), S5W2V(c3, a1.z, a1.w)), pk2(S5W2V(c4, a2.x, a2.y), S5W2V(c5, a2.z, a2.w)), pk2(S5W2V(c6, a3.x, a3.y), S5W2V(c7, a3.z, a3.w))};
#undef S5W2V
        *(u32x4*)(w2 + n * 256 + k0) = o;
    }
}
constexpr int CV_TILES = 800 + 1024 + 256 + 16 + 64 + 128 + 64 + 64 + 2048 * 3;
__device__ __forceinline__ void wave_convert(KP p, int layer, int t) {
    const float* src; int ld, K, ncols, ctiles; size_t dst; int grp = 1 << 30, gstride = 0, row0 = 0; bool zpad = false, wg8 = false, w13 = false, w2 = false;
    if (t < 800) { src = p->in[8] + (size_t)layer * 1024 * 7200; ld = 7200; K = 1024; ncols = 3104; ctiles = 50; dst = WT_WIN; zpad = true; }
    else if ((t -= 800) < 1024) { src = p->in[8] + (size_t)layer * 1024 * 7200 + 3104; ld = 7200; K = 1024; ncols = 4096; ctiles = 64; dst = WT_WG; wg8 = true; }
    else if ((t -= 1024) < 256) { src = p->in[10] + (size_t)layer * 1024 * 1024; ld = 1024; K = 1024; ncols = 1024; ctiles = 16; dst = WT_WMIX; }
    else if ((t -= 256) < 16) { src = p->in[19] + (size_t)layer * 256 * 256; ld = 256; K = 256; ncols = 256; ctiles = 4; dst = WT_WGLU; }
    else if ((t -= 16) < 64) { src = p->in[21] + (size_t)layer * 256 * 1024; ld = 1024; K = 256; ncols = 1024; ctiles = 16; dst = WT_WS5O; }
    else if ((t -= 64) < 128) { src = p->in[25] + (size_t)layer * 512 * 1024; ld = 1024; K = 512; ncols = 1024; ctiles = 16; dst = WT_WGLAO; }
    else if ((t -= 128) < 64) { src = p->in[27] + (size_t)layer * 256 * 1024; ld = 1024; K = 256; ncols = 1024; ctiles = 16; dst = WT_WNAO; }
    else if ((t -= 64) < 64) { src = p->in[32] + (size_t)layer * 256 * 1024; ld = 1024; K = 256; ncols = 1024; ctiles = 16; dst = WT_WCVO; }
    else if ((t -= 64) < 2048) { const int e = t >> 6; t &= 63; src = p->in[37] + ((size_t)layer * 32 + e) * 1024 * 256; ld = 256; K = 1024; ncols = 256; ctiles = 4; dst = WT_W13 + (size_t)e * 512 * 1024; grp = 128; gstride = 256; row0 = 0; w13 = true; }
    else if ((t -= 2048) < 2048) { const int e = t >> 6; t &= 63; src = p->in[38] + ((size_t)layer * 32 + e) * 1024 * 256; ld = 256; K = 1024; ncols = 256; ctiles = 4; dst = WT_W13 + (size_t)e * 512 * 1024; grp = 128; gstride = 256; row0 = 128; w13 = true; }
    else { t -= 2048; const int e = t >> 6; t &= 63; src = p->in[39] + ((size_t)layer * 32 + e) * 256 * 1024; ld = 1024; K = 256; ncols = 1024; ctiles = 16; dst = WT_W2 + (size_t)e * 1024 * 256; w2 = true; }
    const int ct = t % ctiles, kt = t / ctiles, c0 = ct * 64, k0 = kt * 64, lane = tidx() & 63, wave = tidx() >> 6;
    float* tile = (float*)smem + wave * (64 * 65);
    asm volatile("s_waitcnt lgkmcnt(0)" ::: "memory");
    float4 v[16];
#pragma unroll
    for (int ps = 0; ps < 16; ++ps) { const int kk = ps * 4 + (lane >> 4), cq = (lane & 15) * 4;
        v[ps] = (c0 + cq < ncols) ? *(const float4*)(src + (size_t)(k0 + kk) * ld + c0 + cq) : make_float4(0.f, 0.f, 0.f, 0.f); }
#pragma unroll
    for (int ps = 0; ps < 16; ++ps) { const int kk = ps * 4 + (lane >> 4), cq = (lane & 15) * 4;
        tile[kk * 65 + cq] = v[ps].x; tile[kk * 65 + cq + 1] = v[ps].y; tile[kk * 65 + cq + 2] = v[ps].z; tile[kk * 65 + cq + 3] = v[ps].w; }
    asm volatile("s_waitcnt lgkmcnt(0)" ::: "memory");
    const int k8 = (lane & 7) * 8;
#pragma unroll
    for (int ps = 0; ps < 8; ++ps) { const int cc = ps * 8 + (lane >> 3), c = c0 + cc;
        if (c < ncols || zpad) {
            const int row = row0 + (c / grp) * gstride + (c % grp);
            if (w13 || wg8 || w2) {
                const float sc8 = w2 ? 16.f : 32.f;
                uint2 o8; o8.x = f8x4(sc8 * tile[(k8 + 0) * 65 + cc], sc8 * tile[(k8 + 1) * 65 + cc], sc8 * tile[(k8 + 2) * 65 + cc], sc8 * tile[(k8 + 3) * 65 + cc]);
                o8.y = f8x4(sc8 * tile[(k8 + 4) * 65 + cc], sc8 * tile[(k8 + 5) * 65 + cc], sc8 * tile[(k8 + 6) * 65 + cc], sc8 * tile[(k8 + 7) * 65 + cc]);
                unsigned char* d8 = w13 ? (unsigned char*)((bf16_t*)(p->ws + WS_WT) + WT_W13) + (dst - WT_W13) : w2 ? (unsigned char*)((bf16_t*)(p->ws + WS_WT) + WT_W2) + (dst - WT_W2) : p->ws + WS_WG8;
                *(uint2*)(d8 + (size_t)row * (w2 ? 256 : 1024) + k0 + k8) = o8; }
            if (!w13 && !w2) {
            uint4 o; o.x = pk2(tile[(k8 + 0) * 65 + cc], tile[(k8 + 1) * 65 + cc]); o.y = pk2(tile[(k8 + 2) * 65 + cc], tile[(k8 + 3) * 65 + cc]);
            o.z = pk2(tile[(k8 + 4) * 65 + cc], tile[(k8 + 5) * 65 + cc]); o.w = pk2(tile[(k8 + 6) * 65 + cc], tile[(k8 + 7) * 65 + cc]);
            *(uint4*)((bf16_t*)(p->ws + WS_WT) + dst + (size_t)row * K + k0 + k8) = o; } } }
}

__device__ __forceinline__ void phase_norm(KP p, int layer, int which, int u, int nu, bool live = true) {
    const int wave = tidx() >> 6, lane = tidx() & 63;
    const float* g = p->in[which ? 5 : 4] + layer * D;
    bf16_t* H = (bf16_t*)(p->ws + WS_HKV);
    if (which == 1) {
        const char* wsrc = (const char*)((const float*)(p->ws + WS_WR) + (size_t)layer * 36 * 1024) + lane * 16;
        __syncthreads();
#pragma unroll
        for (int k = 0; k < 18; ++k)
            __builtin_amdgcn_global_load_lds((const unsigned*)(wsrc + (k * 8 + wave) * 1024), (LAS unsigned*)((LAS unsigned char*)smem + (k * 8 + wave) * 1024), 16, 0, 0);
        asm volatile("s_waitcnt vmcnt(0)" ::: "memory");
        __syncthreads();
    }
    LAS u32x4* rlist = (LAS u32x4*)((LAS unsigned char*)smem + 147456) + wave * 80;
    int nent = 0;
    for (int r4 = u * 8 + wave; r4 < R / 4; r4 += nu * 8) {
        const int rbase = r4 * 4;
        const bool isctx = (rbase % RB) < CTX;
        if (isctx && which == 1 && layer == 1) continue;
        const float* mv = mod_vec(p, layer, rbase) + (which ? 3072 : 0);
        float4 h[4][4], gs4[4], sh4[4];
#pragma unroll
        for (int i = 0; i < 4; ++i) { const float4 gg = ((const float4*)g)[lane + 64 * i], sc = ((const float4*)(mv + 1024))[lane + 64 * i]; sh4[i] = ((const float4*)mv)[lane + 64 * i];
            gs4[i] = make_float4(gg.x * (1.f + sc.x), gg.y * (1.f + sc.y), gg.z * (1.f + sc.z), gg.w * (1.f + sc.w)); }
        if (!isctx && (which == 1 || layer == 1)) {
            uint2 raw[4][4];
#pragma unroll
            for (int rr = 0; rr < 4; ++rr) { const uint2* xr = (const uint2*)xb_row(p, rbase + rr);
#pragma unroll
                for (int i = 0; i < 4; ++i) raw[rr][i] = xr[lane + 64 * i]; }
#pragma unroll
            for (int rr = 0; rr < 4; ++rr)
#pragma unroll
                for (int i = 0; i < 4; ++i) h[rr][i] = bf4(raw[rr][i]);
        } else {
#pragma unroll
            for (int rr = 0; rr < 4; ++rr) { const float* xr = which ? (const float*)xdst_row(p, rbase + rr) : xsrc_row(p, layer, rbase + rr);
#pragma unroll
                for (int i = 0; i < 4; ++i) h[rr][i] = ((const float4*)xr)[lane + 64 * i]; }
        }
        float ss4[4];
#pragma unroll
        for (int rr = 0; rr < 4; ++rr) { float ss = 0.f;
#pragma unroll
            for (int i = 0; i < 4; ++i) { const float4 v = h[rr][i]; ss += v.x * v.x + v.y * v.y + v.z * v.z + v.w * v.w; }
            ss4[rr] = ss; }
#pragma unroll
        for (int rr = 0; rr < 4; ++rr) ss4[rr] = wave_sum(ss4[rr]);
#pragma unroll
        for (int rr = 0; rr < 4; ++rr) {
            const float rs = rsqrtf(ss4[rr] * (1.f / D) + 1e-6f);
#pragma unroll
            for (int i = 0; i < 4; ++i) {
                const float4 gs = gs4[i], sh = sh4[i];
                float4 v = h[rr][i];
                v.x = v.x * rs * gs.x + sh.x; v.y = v.y * rs * gs.y + sh.y; v.z = v.z * rs * gs.z + sh.z; v.w = v.w * rs * gs.w + sh.w;
                h[rr][i] = v;
                uint2 o; o.x = pk2(v.x, v.y); o.y = pk2(v.z, v.w);
                if (which == 0) *(uint2*)(H + (size_t)(rbase + rr) * D + (lane + 64 * i) * 4) = o;
                if (which == 1 || !isctx || layer == 0) *(unsigned*)((unsigned char*)p->out + OUT_H8 + (size_t)(rbase + rr) * D + (lane + 64 * i) * 4) = f8x4(v.x, v.y, v.z, v.w);
            }
        }
        if (which == 1) {
            const LAS f32x4* wl = (const LAS f32x4*)smem;
            float gl[4][4];
#pragma unroll
            for (int o = 0; o < 4; ++o) {
                float a0 = 0.f, a1 = 0.f, a2 = 0.f, a3 = 0.f;
#pragma unroll
                for (int i = 0; i < 4; ++i) { const f32x4 wv = wl[o * 256 + lane + 64 * i]; const float4 w = {wv[0], wv[1], wv[2], wv[3]};
                    a0 += h[0][i].x * w.x + h[0][i].y * w.y + h[0][i].z * w.z + h[0][i].w * w.w; a1 += h[1][i].x * w.x + h[1][i].y * w.y + h[1][i].z * w.z + h[1][i].w * w.w;
                    a2 += h[2][i].x * w.x + h[2][i].y * w.y + h[2][i].z * w.z + h[2][i].w * w.w; a3 += h[3][i].x * w.x + h[3][i].y * w.y + h[3][i].z * w.z + h[3][i].w * w.w; }
                const float bg = p->in[34][layer * 4 + o];
                gl[0][o] = wave_sum(a0) + bg; gl[1][o] = wave_sum(a1) + bg; gl[2][o] = wave_sum(a2) + bg; gl[3][o] = wave_sum(a3) + bg;
            }
#pragma unroll
            for (int rr = 0; rr < 4; ++rr) {
                int gi = 0; float gm = gl[rr][0];
#pragma unroll
                for (int j = 1; j < 4; ++j) if (gl[rr][j] > gm) { gm = gl[rr][j]; gi = j; }
                float den = 0.f;
#pragma unroll
                for (int j = 0; j < 4; ++j) den += expf(gl[rr][j] - gm);
                const float gp = 1.f / den;
                gi = __builtin_amdgcn_readfirstlane(gi);
                float ev[8];
#pragma unroll
                for (int e = 0; e < 8; ++e) { float a = 0.f; const LAS f32x4* we = wl + (4 + gi * 8 + e) * 256;
#pragma unroll
                    for (int i = 0; i < 4; ++i) { const f32x4 wv = we[lane + 64 * i]; const float4 w = {wv[0], wv[1], wv[2], wv[3]}; a += h[rr][i].x * w.x + h[rr][i].y * w.y + h[rr][i].z * w.z + h[rr][i].w * w.w; }
                    ev[e] = a; }
#pragma unroll
                for (int e = 0; e < 8; ++e) ev[e] = wave_sum(ev[e]) + p->in[36][layer * 32 + gi * 8 + e];
                float v1 = -3.0e38f, v2 = -3.0e38f; int e1 = 0, e2 = 0;
#pragma unroll
                for (int e = 0; e < 8; ++e) { const float v = ev[e]; if (v > v1) { v2 = v1; e2 = e1; v1 = v; e1 = e; } else if (v > v2) { v2 = v; e2 = e; } }
                if (lane == 0) {
                    const float p1 = 1.f / (1.f + expf(v2 - v1)), p2 = 1.f - p1;
                    int ea = e1, eb = e2; float wa = p1 * gp, wb = p2 * gp;
                    if (ea > eb) { const int t = ea; ea = eb; eb = t; const float tw = wa; wa = wb; wb = tw; }
                    const int cls = gi * 28 + (ea * (15 - ea)) / 2 + (eb - ea - 1), row = rbase + rr;
                    rlist[nent + rr] = (u32x4){(unsigned)cls, (unsigned)row, __float_as_uint(wa), __float_as_uint(wb)};
                }
            }
            nent += 4;
        }
    }
    if (which == 1 && live) {
        asm volatile("s_waitcnt lgkmcnt(0)" ::: "memory");
        unsigned* cnt = (unsigned*)(p->ws + WS_CTL + CTL_CNT) + layer * 128 * 64;
        for (int i = lane; i < nent; i += 64) { const u32x4 e = rlist[i];
            const unsigned pos = atomicAdd(&cnt[e[0] * 64], 1u);
            ((int*)(p->ws + WS_PROJ + PJ_PERM))[(size_t)e[0] * MOE_CAP + pos] = (int)e[1];
            ((float2*)(p->ws + WS_PROJ + PJ_TOKW))[e[1]] = make_float2(__uint_as_float(e[2]), __uint_as_float(e[3])); }
    }
}

__device__ __forceinline__ bool xcd_unit_split(int bid, int nb, int i, int npanel, int ncol, int csplit, int& pm, int& pn) {
    const int xcd = bid & 7, rank = bid >> 3, nrank = nb >> 3;
    const int p0 = (npanel * xcd) >> 3, p1 = (npanel * (xcd + 1)) >> 3, np = p1 - p0, j = rank + i * nrank;
    if (j >= np * ncol) return false;
    if (j < np * csplit) { pm = p0 + j / csplit; pn = j % csplit; }
    else { const int j2 = j - np * csplit, c2 = ncol - csplit; pm = p0 + j2 / c2; pn = csplit + j2 % c2; }
    return true;
}
__device__ __forceinline__ bool xcd_unit(int bid, int nb, int i, int npanel, int ncol, int& pm, int& pn) {
    const int xcd = bid & 7, rank = bid >> 3, nrank = nb >> 3;
    const int p0 = (npanel * xcd) >> 3, p1 = (npanel * (xcd + 1)) >> 3, j = rank + i * nrank;
    if (j >= (p1 - p0) * ncol) return false;
    pm = p0 + j / ncol; pn = j % ncol; return true;
}
typedef const bf16_t* cbfp;
__device__ __forceinline__ void phase_inproj(KP p, int bid, int nb) {
    const char* H = (const char*)(p->ws + WS_HKV); const char* W = (const char*)((const bf16_t*)(p->ws + WS_WT) + WT_WIN); bf16_t* P = (bf16_t*)(p->ws + WS_PROJ);
    gemm256<true>(smem,
        [&](int i, U256& u) -> bool { int pm, pn; if (!xcd_unit_split(bid, nb, i, 132, 13, 7, pm, pn)) return false;
            u.A = H + (size_t)pm * 256 * D * 2; u.B = W + (size_t)pn * 256 * D * 2; u.K = D; return true; },
        [&](int i, f32x4 (&acc)[2][2][4][2], int wr, int wc, int fr, int fq) {
            int pm, pn; xcd_unit_split(bid, nb, i, 132, 13, 7, pm, pn);
            const int b = pm / 33, i0 = (pm % 33) * 256;
#pragma unroll
            for (int bj = 0; bj < 2; ++bj) { const int col = pn * 256 + bj * 128 + wc * 32 + fq * 8;
                if (col < NPROJ) {
                    size_t base; int rs_hi, rs_lo;
                    if (col < 256) { base = O_U + ((size_t)((b * 528 + (i0 >> 4)) * 16 + (col >> 4))) * 256 + (col & 15); rs_hi = 4096; rs_lo = 16; }
                    else if (col >= C_GA && col < C_NQ) { base = O_GA + (size_t)(b * RB + i0) * 32 + (col - C_GA); rs_hi = 512; rs_lo = 32; }
                    else if (col >= C_CV) { base = O_CV + (size_t)(b * RB + i0) * 512 + (col - C_CV); rs_hi = 8192; rs_lo = 512; }
                    else { size_t o; int cc, w;
                        if (col < C_GK) { o = O_GQ; cc = col - C_GQ; w = 64; } else if (col < C_GV) { o = O_GK; cc = col - C_GK; w = 64; }
                        else if (col < C_GR) { o = O_GV; cc = col - C_GV; w = 128; } else if (col < C_GA) { o = O_GR; cc = col - C_GR; w = 128; }
                        else if (col < C_NK) { o = O_NQ; cc = col - C_NQ; w = 64; } else if (col < C_NV) { o = O_NK; cc = col - C_NK; w = 64; } else { o = O_NV; cc = col - C_NV; w = 64; }
                        const int hh = cc / w, dd = cc % w;
                        base = o + ((size_t)(b * 4 + hh) * RB + i0) * w + dd; rs_hi = 16 * w; rs_lo = w; }
                    bf16_t* dst = P + base + (size_t)fr * rs_lo;
#pragma unroll
                    for (int ai = 0; ai < 2; ++ai)
#pragma unroll
                        for (int m = 0; m < 4; ++m) { uint4 o; o.x = pk2(acc[ai][bj][m][0][0], acc[ai][bj][m][0][1]); o.y = pk2(acc[ai][bj][m][0][2], acc[ai][bj][m][0][3]);
                            o.z = pk2(acc[ai][bj][m][1][0], acc[ai][bj][m][1][1]); o.w = pk2(acc[ai][bj][m][1][2], acc[ai][bj][m][1][3]);
                            *(uint4*)(dst + (size_t)(ai * 8 + wr * 4 + m) * rs_hi) = o; }
                } } });
}

__device__ __forceinline__ void phase_s5_gemm1(KP p, int layer, int bid, int nb) {
    typedef GT<128, 128, 2, 4> G;
    const int tid = tidx(), lane = tid & 63, wave = tid >> 6, wm = wave >> 2, wn = wave & 3, fr = lane & 15, fq = lane >> 4;
    const bf16_t* P = (const bf16_t*)(p->ws + WS_PROJ); bf16_t* Y = (bf16_t*)(p->ws + WS_YSUM); float* GU = (float*)(p->ws + WS_GU);
    gemm_stream<128, 128, 2, 4>(
        [&](int s, cbfp (&ap)[G::AI], long& kstep, cbfp (&bp)[G::BI], int& nk) -> bool {
            const int u = bid + s * nb; if (u >= 17 * 64) return false; const int mtile = u / 64, g = (u / 4) % 16, pn = u % 4;
            const bf16_t* W = (const bf16_t*)(p->ws + WS_S5W1) + ((size_t)layer * 16 + g) * 512 * 256;
#pragma unroll
            for (int i = 0; i < G::AI; ++i) { int ch = mtile * 128 + st_row(i); ch = ch < NCH16 ? ch : NCH16 - 1; const int c = st_chunk(i);
                ap[i] = P + O_U + ((size_t)ch * 16 + g) * 256 + c * 8; }
#pragma unroll
            for (int i = 0; i < G::BI; ++i) bp[i] = W + (size_t)(pn * 128 + st_row(i)) * 256 + st_chunk(i) * 8;
            kstep = 64; nk = 4; return true; },
        [&](int s, f32x4 (&acc)[G::MT][G::NTL]) {
            const int u = bid + s * nb, mtile = u / 64, g = (u / 4) % 16, pn = u % 4;
#pragma unroll
            for (int mt = 0; mt < G::MT; ++mt)
#pragma unroll
                for (int nt = 0; nt < G::NTL; ++nt) {
                    const int ch = mtile * 128 + wm * 64 + mt * 16 + fr, n = pn * 128 + wn * 32 + nt * 16 + fq * 4;
                    if (ch < NCH16) {
                        if (n < 256) { uint2 o; o.x = pk2(acc[mt][nt][0], acc[mt][nt][1]); o.y = pk2(acc[mt][nt][2], acc[mt][nt][3]);
                            *(uint2*)(Y + (size_t)(ch * 16 + (n >> 4)) * 256 + g * 16 + (n & 15)) = o; }
                        else *(f32x4*)(GU + ((size_t)ch * 16 + g) * 256 + (n - 256)) = acc[mt][nt];
                    }
                }
            ZERO_ACC(acc, G::MT, G::NTL); },
        smem);
}
__device__ __forceinline__ int s5_order(int d, int i) { return d == 0 ? i : (i < 16 ? 15 - i : 543 - i); }
__device__ __forceinline__ void unit_s5_scan(KP p, int layer, int u) {
    const int b = u >> 5, g = (u >> 1) & 15, d = u & 1, wave = tidx() >> 6, lane = tidx() & 63;
    const float2 A = ((const float2*)(p->ws + WS_A16))[(((size_t)layer * 2 + d) * 16 + g) * 64 + lane];
    const float* GU = (const float*)(p->ws + WS_GU); bf16_t* HIN = (bf16_t*)(p->ws + WS_HIN);
    float2* tot = (float2*)smem;
    __syncthreads();
    float hr = 0.f, hi = 0.f;
    for (int i0 = 0; i0 < 66; i0 += 22) {
        float gr[22], gim[22];
#pragma unroll
        for (int j = 0; j < 22; ++j) { const size_t ch = (size_t)b * 528 + s5_order(d, wave * 66 + i0 + j); gr[j] = GU[(ch * 16 + g) * 256 + d * 128 + lane]; gim[j] = GU[(ch * 16 + g) * 256 + d * 128 + 64 + lane]; }
#pragma unroll
        for (int j = 0; j < 22; ++j) { const float nr = A.x * hr - A.y * hi + gr[j], ni = A.x * hi + A.y * hr + gim[j]; hr = nr; hi = ni; }
    }
    tot[wave * 64 + lane] = make_float2(hr, hi);
    float a66r = 1.f, a66i = 0.f;
    for (int i = 0; i < 66; ++i) { const float nr = a66r * A.x - a66i * A.y, ni = a66r * A.y + a66i * A.x; a66r = nr; a66i = ni; }
    __syncthreads();
    hr = 0.f; hi = 0.f;
    for (int w = 0; w < wave; ++w) { const float2 t = tot[w * 64 + lane]; const float nr = a66r * hr - a66i * hi + t.x, ni = a66r * hi + a66i * hr + t.y; hr = nr; hi = ni; }
    for (int i0 = 0; i0 < 66; i0 += 22) {
        float gr[22], gim[22]; size_t chs[22];
#pragma unroll
        for (int j = 0; j < 22; ++j) { const size_t ch = (size_t)b * 528 + s5_order(d, wave * 66 + i0 + j); chs[j] = ch; gr[j] = GU[(ch * 16 + g) * 256 + d * 128 + lane]; gim[j] = GU[(ch * 16 + g) * 256 + d * 128 + 64 + lane]; }
#pragma unroll
        for (int j = 0; j < 22; ++j) {
            HIN[(chs[j] * 16 + g) * 256 + d * 128 + lane] = (bf16_t)f2bf(hr); HIN[(chs[j] * 16 + g) * 256 + d * 128 + 64 + lane] = (bf16_t)f2bf(hi);
            const float nr = A.x * hr - A.y * hi + gr[j], ni = A.x * hi + A.y * hr + gim[j]; hr = nr; hi = ni; }
    }
}
__device__ __forceinline__ void phase_s5_gemm2(KP p, int layer, int bid, int nb, bool live = true) {
    typedef GT<128, 128, 2, 4> G;
    const int tid = tidx(), lane = tid & 63, wave = tid >> 6, wm = wave >> 2, wn = wave & 3, fr = lane & 15, fq = lane >> 4;
    const bf16_t* HIN = (const bf16_t*)(p->ws + WS_HIN); bf16_t* Y = (bf16_t*)(p->ws + WS_YSUM);
    gemm_stream<128, 128, 2, 4>(
        [&](int s, cbfp (&ap)[G::AI], long& kstep, cbfp (&bp)[G::BI], int& nk) -> bool {
            const int u = bid + s * nb; if (u >= 17 * 32) return false; const int mtile = u / 32, g = (u / 2) % 16, pn = u % 2;
            const bf16_t* W = (const bf16_t*)(p->ws + WS_S5W2) + ((size_t)layer * 16 + g) * 256 * 256;
#pragma unroll
            for (int i = 0; i < G::AI; ++i) { int ch = mtile * 128 + st_row(i); ch = ch < NCH16 ? ch : NCH16 - 1; ap[i] = HIN + ((size_t)ch * 16 + g) * 256 + st_chunk(i) * 8; }
#pragma unroll
            for (int i = 0; i < G::BI; ++i) bp[i] = W + (size_t)(pn * 128 + st_row(i)) * 256 + st_chunk(i) * 8;
            kstep = 64; nk = 4; return true; },
        [&](int s, f32x4 (&acc)[G::MT][G::NTL]) {
            const int u = bid + s * nb, mtile = u / 32, g = (u / 2) % 16, pn = u % 2;
#pragma unroll
            for (int mt = 0; mt < G::MT; ++mt)
#pragma unroll
                for (int nt = 0; nt < G::NTL; ++nt) {
                    const int ch = mtile * 128 + wm * 64 + mt * 16 + fr, n = pn * 128 + wn * 32 + nt * 16 + fq * 4;
                    if (ch < NCH16) { uint2* q = (uint2*)(Y + (size_t)(ch * 16 + (n >> 4)) * 256 + g * 16 + (n & 15)); const uint2 y = *q;
                        uint2 o; o.x = pk2(gelu_t(acc[mt][nt][0] + bf2f(y.x & 0xFFFFu)), gelu_t(acc[mt][nt][1] + bf2f(y.x >> 16)));
                        o.y = pk2(gelu_t(acc[mt][nt][2] + bf2f(y.y & 0xFFFFu)), gelu_t(acc[mt][nt][3] + bf2f(y.y >> 16))); if (live) *q = o; }
                }
            ZERO_ACC(acc, G::MT, G::NTL); },
        smem);
}
__device__ __forceinline__ void phase_s5_glu(KP p, int layer, int bid, int nb) {
    typedef GT<256, 128, 4, 2> G;
    const int tid = tidx(), lane = tid & 63, wave = tid >> 6, wm = wave >> 1, wn = wave & 1, fr = lane & 15, fq = lane >> 4;
    const bf16_t* Zp = (const bf16_t*)(p->ws + WS_YSUM); const bf16_t* W = (const bf16_t*)(p->ws + WS_WT) + WT_WGLU;
    bf16_t* Z = (bf16_t*)(p->ws + WS_ZS5); const float* bg = p->in[20] + layer * 256;
    gemm_stream<256, 128, 4, 2>(
        [&](int s, cbfp (&ap)[G::AI], long& kstep, cbfp (&bp)[G::BI], int& nk) -> bool {
            const int u = bid + s * nb; if (u >= 132 * 2) return false; const int pm = u >> 1, pn = u & 1;
#pragma unroll
            for (int i = 0; i < G::AI; ++i) ap[i] = Zp + (size_t)(pm * 256 + st_row(i)) * 256 + st_chunk(i) * 8;
#pragma unroll
            for (int i = 0; i < G::BI; ++i) bp[i] = W + (size_t)(pn * 128 + st_row(i)) * 256 + st_chunk(i) * 8;
            kstep = 64; nk = 4; return true; },
        [&](int s, f32x4 (&acc)[G::MT][G::NTL]) {
            const int u = bid + s * nb, pm = u >> 1, pn = u & 1;
#pragma unroll
            for (int mt = 0; mt < G::MT; ++mt)
#pragma unroll
                for (int nt = 0; nt < G::NTL; ++nt) {
                    const int row = pm * 256 + wm * 64 + mt * 16 + fr, col = pn * 128 + wn * 64 + nt * 16 + fq * 4;
                    const uint2 z = *(const uint2*)(Zp + (size_t)row * 256 + col); const float4 bb = *(const float4*)(bg + col);
                    uint2 o; o.x = pk2(bf2f(z.x & 0xFFFFu) * sigm(acc[mt][nt][0] + bb.x), bf2f(z.x >> 16) * sigm(acc[mt][nt][1] + bb.y));
                    o.y = pk2(bf2f(z.y & 0xFFFFu) * sigm(acc[mt][nt][2] + bb.z), bf2f(z.y >> 16) * sigm(acc[mt][nt][3] + bb.w));
                    *(uint2*)(Z + (size_t)row * 256 + col) = o;
                }
            ZERO_ACC(acc, G::MT, G::NTL); },
        smem);
}

__device__ __forceinline__ void unit_conv(KP p, int layer, int u) {
    const int r0 = u * 64, tid = tidx(), i0 = r0 % RB;
    const int seq_lo = r0 - i0 + (i0 < CTX ? 0 : CTX), seq_hi = r0 - i0 + (i0 < CTX ? CTX : RB);
    bf16_t* gl = (bf16_t*)smem;
    float* co = (float*)(smem + 94 * 256 * 2);
    const bf16_t* P = (const bf16_t*)(p->ws + WS_PROJ);
    __syncthreads();
    {
        uint2 vv[12], gg[12];
#pragma unroll
        for (int k = 0; k < 12; ++k) { const int i = tid + k * NT, rr = i >> 6, c4 = (i & 63) * 4, row = r0 - 15 + rr; vv[k] = make_uint2(0u, 0u); gg[k] = make_uint2(0u, 0u);
            if (i < 94 * 64 && row >= seq_lo && row < seq_hi) { vv[k] = *(const uint2*)(P + O_CV + (size_t)row * 512 + c4); gg[k] = *(const uint2*)(P + O_CV + (size_t)row * 512 + 256 + c4); } }
#pragma unroll
        for (int k = 0; k < 12; ++k) { const int i = tid + k * NT, rr = i >> 6, c4 = (i & 63) * 4; const uint2 v = vv[k], gt = gg[k]; uint2 o;
            o.x = pk2(bf2f(v.x & 0xFFFFu) * sigm(bf2f(gt.x & 0xFFFFu)), bf2f(v.x >> 16) * sigm(bf2f(gt.x >> 16)));
            o.y = pk2(bf2f(v.y & 0xFFFFu) * sigm(bf2f(gt.y & 0xFFFFu)), bf2f(v.y >> 16) * sigm(bf2f(gt.y >> 16)));
            if (i < 94 * 64) *(uint2*)(gl + rr * 256 + c4) = o; }
    }
    const int cp = tid & 127, rg = tid >> 7;
    float2 w[31];
#pragma unroll
    for (int j = 0; j < 31; ++j) w[j] = *(const float2*)(p->in[28] + ((size_t)layer * 31 + j) * 256 + 2 * cp);
    const float2 bias = *(const float2*)(p->in[29] + layer * 256 + 2 * cp);
    __syncthreads();
    {
        float x0[46], x1[46];
#pragma unroll
        for (int i = 0; i < 46; ++i) { const unsigned v = *(const unsigned*)(gl + (rg * 16 + i) * 256 + 2 * cp); x0[i] = __uint_as_float(v << 16); x1[i] = __uint_as_float(v & 0xFFFF0000u); }
#pragma unroll
        for (int t = 0; t < 16; ++t) { float s0 = bias.x, s1 = bias.y;
#pragma unroll
            for (int j = 0; j < 31; ++j) { s0 = __builtin_fmaf(w[j].x, x0[t + j], s0); s1 = __builtin_fmaf(w[j].y, x1[t + j], s1); }
            *(float2*)(co + (rg * 16 + t) * 256 + 2 * cp) = make_float2(s0, s1); }
    }
    __syncthreads();
    const int wave = tid >> 6, lane = tid & 63;
    const float4 lg = *(const float4*)(p->in[30] + layer * 256 + lane * 4), lb = *(const float4*)(p->in[31] + layer * 256 + lane * 4);
    bf16_t* Z = (bf16_t*)(p->ws + WS_ZCV);
    for (int t = wave * 8; t < wave * 8 + 8; ++t) {
        const float4 v = *(const float4*)(co + t * 256 + lane * 4);
        const float mean = wave_sum(v.x + v.y + v.z + v.w) * (1.f / 256.f);
        const float dx = v.x - mean, dy = v.y - mean, dz = v.z - mean, dw = v.w - mean;
        const float rs = rsqrtf(wave_sum(dx * dx + dy * dy + dz * dz + dw * dw) * (1.f / 256.f) + 1e-6f);
        float a = dx * rs * lg.x + lb.x, b = dy * rs * lg.y + lb.y, cc = dz * rs * lg.z + lb.z, d = dw * rs * lg.w + lb.w;
        a *= sigm(a); b *= sigm(b); cc *= sigm(cc); d *= sigm(d);
        uint2 o; o.x = pk2(a, b); o.y = pk2(cc, d);
        *(uint2*)(Z + (size_t)(r0 + t) * 256 + lane * 4) = o;
    }
}

constexpr int NA_LQ = 144, NA_LP = 272;
typedef short s16x4 __attribute__((ext_vector_type(4)));
__device__ __forceinline__ bf16x8 na_pfrag(const f32x4& a, const f32x4& b) { const uint4 w = make_uint4(pk2(a[0], a[1]), pk2(a[2], a[3]), pk2(b[0], b[1]), pk2(b[2], b[3])); return __builtin_bit_cast(bf16x8, w); }
__device__ __forceinline__ void unit_na(KP p, int layer, int u) {
    const int tid = tidx(), lane = tid & 63, wave = tid >> 6, fr = lane & 15, fq = lane >> 4, mtw = wave & 3, kh = wave >> 2;
    int b, h, r = 0, qrow0, t_lo; bool lat = u < 2048;
    if (lat) { b = u >> 9; h = (u >> 7) & 3; r = u & 127; qrow0 = b * RB + CTX + r * 64; t_lo = 0; }
    else { const int v = u - 2048; b = v >> 4; h = (v >> 2) & 3; qrow0 = b * RB + (v & 3) * 64; t_lo = 2; }
    const int hrow0 = (b * 4 + h) * RB;
    const int row_start = r - 4 < 0 ? 0 : (r - 4 > 120 ? 120 : r - 4);
    unsigned char* Ql = smem;
    unsigned char* Kl = Ql + 64 * NA_LQ;
    unsigned char* Vl = Kl + 256 * NA_LQ;
    unsigned char* Pl = Vl + 256 * NA_LQ;
    float* rpb = (float*)(Pl + 8 * 16 * NA_LP);
    float* mrg = rpb + 480;
    const bf16_t* P = (const bf16_t*)(p->ws + WS_PROJ);
    __syncthreads();
    { const int q = tid >> 3, c = tid & 7; const uint4 v = *(const uint4*)(P + O_NQ + (size_t)(hrow0 + (qrow0 - b * RB) + q) * 64 + c * 8); uint4 w;
      w.x = pk2(bf2f(v.x & 0xFFFFu) * 0.125f, bf2f(v.x >> 16) * 0.125f); w.y = pk2(bf2f(v.y & 0xFFFFu) * 0.125f, bf2f(v.y >> 16) * 0.125f);
      w.z = pk2(bf2f(v.z & 0xFFFFu) * 0.125f, bf2f(v.z >> 16) * 0.125f); w.w = pk2(bf2f(v.w & 0xFFFFu) * 0.125f, bf2f(v.w >> 16) * 0.125f);
      *(uint4*)(Ql + q * NA_LQ + c * 16) = w; }
    for (int i = tid; i < 465; i += NT) rpb[i] = p->in[26][((size_t)layer * 4 + h) * 465 + i];
    float m_run = -1e30f, l_run = 0.f; f32x4 o[4];
    const int cb = mtw == 0 ? 0 : (mtw == 3 ? 32 : 16 * mtw - 8);
    int dcm[2][4];
#pragma unroll
    for (int nt = 0; nt < 4; ++nt) o[nt] = (f32x4){0.f, 0.f, 0.f, 0.f};
#pragma unroll
    for (int n = 0; n < 2; ++n)
#pragma unroll
        for (int j = 0; j < 4; ++j) { const int cq = mtw * 16 + fr, ck = cb + n * 16 + 4 * fq + j; int cs = cq - 8; cs = cs < 0 ? 0 : (cs > 48 ? 48 : cs);
            int dc = ck - cq + 15; dc = dc < 0 ? 0 : (dc > 30 ? 30 : dc); dcm[n][j] = (ck >= cs && ck < cs + 16) ? dc : -1; }
    uint4 kg00 = make_uint4(0u, 0u, 0u, 0u), vg00 = make_uint4(0u, 0u, 0u, 0u), kg01 = make_uint4(0u, 0u, 0u, 0u), vg01 = make_uint4(0u, 0u, 0u, 0u), kg02 = make_uint4(0u, 0u, 0u, 0u), vg02 = make_uint4(0u, 0u, 0u, 0u), kg03 = make_uint4(0u, 0u, 0u, 0u), vg03 = make_uint4(0u, 0u, 0u, 0u), kg10 = make_uint4(0u, 0u, 0u, 0u), vg10 = make_uint4(0u, 0u, 0u, 0u), kg11 = make_uint4(0u, 0u, 0u, 0u), vg11 = make_uint4(0u, 0u, 0u, 0u), kg12 = make_uint4(0u, 0u, 0u, 0u), vg12 = make_uint4(0u, 0u, 0u, 0u), kg13 = make_uint4(0u, 0u, 0u, 0u), vg13 = make_uint4(0u, 0u, 0u, 0u), kg20 = make_uint4(0u, 0u, 0u, 0u), vg20 = make_uint4(0u, 0u, 0u, 0u), kg21 = make_uint4(0u, 0u, 0u, 0u), vg21 = make_uint4(0u, 0u, 0u, 0u), kg22 = make_uint4(0u, 0u, 0u, 0u), vg22 = make_uint4(0u, 0u, 0u, 0u), kg23 = make_uint4(0u, 0u, 0u, 0u), vg23 = make_uint4(0u, 0u, 0u, 0u);
    const int ko0 = (hrow0 + CTX + row_start * 64 + (tid >> 3)) * 64 + (tid & 7) * 8;
    const int ctx_delta = -(CTX + row_start * 64) * 64;
    if (0 >= t_lo) { kg00 = *(const uint4*)(P + O_NK + (size_t)(unsigned)(ko0 + 0 * 256 * 64 + 0 * 64 * 64)); vg00 = *(const uint4*)(P + O_NV + (size_t)(unsigned)(ko0 + 0 * 256 * 64 + 0 * 64 * 64)); kg01 = *(const uint4*)(P + O_NK + (size_t)(unsigned)(ko0 + 0 * 256 * 64 + 1 * 64 * 64)); vg01 = *(const uint4*)(P + O_NV + (size_t)(unsigned)(ko0 + 0 * 256 * 64 + 1 * 64 * 64)); kg02 = *(const uint4*)(P + O_NK + (size_t)(unsigned)(ko0 + 0 * 256 * 64 + 2 * 64 * 64)); vg02 = *(const uint4*)(P + O_NV + (size_t)(unsigned)(ko0 + 0 * 256 * 64 + 2 * 64 * 64)); kg03 = *(const uint4*)(P + O_NK + (size_t)(unsigned)(ko0 + 0 * 256 * 64 + 3 * 64 * 64)); vg03 = *(const uint4*)(P + O_NV + (size_t)(unsigned)(ko0 + 0 * 256 * 64 + 3 * 64 * 64)); }
    if (1 >= t_lo) { kg10 = *(const uint4*)(P + O_NK + (size_t)(unsigned)(ko0 + 1 * 256 * 64 + 0 * 64 * 64)); vg10 = *(const uint4*)(P + O_NV + (size_t)(unsigned)(ko0 + 1 * 256 * 64 + 0 * 64 * 64)); kg11 = *(const uint4*)(P + O_NK + (size_t)(unsigned)(ko0 + 1 * 256 * 64 + 1 * 64 * 64)); vg11 = *(const uint4*)(P + O_NV + (size_t)(unsigned)(ko0 + 1 * 256 * 64 + 1 * 64 * 64)); kg12 = *(const uint4*)(P + O_NK + (size_t)(unsigned)(ko0 + 1 * 256 * 64 + 2 * 64 * 64)); vg12 = *(const uint4*)(P + O_NV + (size_t)(unsigned)(ko0 + 1 * 256 * 64 + 2 * 64 * 64)); kg13 = *(const uint4*)(P + O_NK + (size_t)(unsigned)(ko0 + 1 * 256 * 64 + 3 * 64 * 64)); vg13 = *(const uint4*)(P + O_NV + (size_t)(unsigned)(ko0 + 1 * 256 * 64 + 3 * 64 * 64)); }
    if (2 >= t_lo) { kg20 = *(const uint4*)(P + O_NK + (size_t)(unsigned)(ko0 + ctx_delta + 0 * 64 * 64)); vg20 = *(const uint4*)(P + O_NV + (size_t)(unsigned)(ko0 + ctx_delta + 0 * 64 * 64)); kg21 = *(const uint4*)(P + O_NK + (size_t)(unsigned)(ko0 + ctx_delta + 1 * 64 * 64)); vg21 = *(const uint4*)(P + O_NV + (size_t)(unsigned)(ko0 + ctx_delta + 1 * 64 * 64)); kg22 = *(const uint4*)(P + O_NK + (size_t)(unsigned)(ko0 + ctx_delta + 2 * 64 * 64)); vg22 = *(const uint4*)(P + O_NV + (size_t)(unsigned)(ko0 + ctx_delta + 2 * 64 * 64)); kg23 = *(const uint4*)(P + O_NK + (size_t)(unsigned)(ko0 + ctx_delta + 3 * 64 * 64)); vg23 = *(const uint4*)(P + O_NV + (size_t)(unsigned)(ko0 + ctx_delta + 3 * 64 * 64)); }
#define NA_PUT(K_, V_, e_) do { *(uint4*)(Kl + ((tid >> 3) + (e_) * 64) * NA_LQ + (tid & 7) * 16) = (K_); *(uint4*)(Vl + ((tid >> 3) + (e_) * 64) * NA_LQ + (tid & 7) * 16) = (V_); } while (0)
#pragma unroll
    for (int t = 0; t < 3; ++t) if (t >= t_lo) {
        __syncthreads();
        if (t == 0) { NA_PUT(kg00, vg00, 0); NA_PUT(kg01, vg01, 1); NA_PUT(kg02, vg02, 2); NA_PUT(kg03, vg03, 3); }
        else if (t == 1) { NA_PUT(kg10, vg10, 0); NA_PUT(kg11, vg11, 1); NA_PUT(kg12, vg12, 2); NA_PUT(kg13, vg13, 3); }
        else { NA_PUT(kg20, vg20, 0); NA_PUT(kg21, vg21, 1); NA_PUT(kg22, vg22, 2); NA_PUT(kg23, vg23, 3); }
        __syncthreads();
        if (t < 2) {
            f32x4 s0[2] = {}, s1[2] = {};
            wave_mma_t<2, 2>(s0, Ql + mtw * 16 * NA_LQ, NA_LQ, Kl + (kh * 128 + cb) * NA_LQ, NA_LQ);
            wave_mma_t<2, 2>(s1, Ql + mtw * 16 * NA_LQ, NA_LQ, Kl + (kh * 128 + 64 + cb) * NA_LQ, NA_LQ);
            const float* rb = rpb + (row_start + 4 * t + 2 * kh - r + 7) * 31;
#pragma unroll
            for (int n = 0; n < 2; ++n)
#pragma unroll
                for (int j = 0; j < 4; ++j) { s0[n][j] = dcm[n][j] >= 0 ? s0[n][j] + rb[dcm[n][j]] : -1e30f; s1[n][j] = dcm[n][j] >= 0 ? s1[n][j] + rb[31 + dcm[n][j]] : -1e30f; }
            float mx = -1e30f;
#pragma unroll
            for (int n = 0; n < 2; ++n) mx = fmaxf(mx, fmaxf(fmaxf(fmaxf(s0[n][0], s0[n][1]), fmaxf(s0[n][2], s0[n][3])), fmaxf(fmaxf(s1[n][0], s1[n][1]), fmaxf(s1[n][2], s1[n][3]))));
            mx = fmaxf(mx, __shfl_xor(mx, 16)); mx = fmaxf(mx, __shfl_xor(mx, 32));
            const float mn = fmaxf(m_run, mx), al = __expf(m_run - mn); m_run = mn;
            float rs = 0.f;
#pragma unroll
            for (int n = 0; n < 2; ++n)
#pragma unroll
                for (int j = 0; j < 4; ++j) { const float e0 = __expf(s0[n][j] - mn), e1 = __expf(s1[n][j] - mn); s0[n][j] = e0; s1[n][j] = e1; rs += e0 + e1; }
            rs += __shfl_xor(rs, 16); rs += __shfl_xor(rs, 32);
            l_run = l_run * al + rs;
#pragma unroll
            for (int nt = 0; nt < 4; ++nt) o[nt] *= al;
            const bf16x8 pfa = na_pfrag(s0[0], s0[1]), pfb = na_pfrag(s1[0], s1[1]);
            const unsigned char* vb = Vl + (kh * 128 + cb + 4 * fq + (fr >> 2)) * NA_LQ + (fr & 3) * 8;
#pragma unroll
            for (int ks = 0; ks < 2; ++ks) { const bf16x8 pf = ks ? pfb : pfa;
#pragma unroll
                for (int nt = 0; nt < 4; ++nt) {
                    const s16x4 v0 = __builtin_amdgcn_ds_read_tr16_b64_v4i16((LAS s16x4*)(vb + ks * 64 * NA_LQ + nt * 32)), v1 = __builtin_amdgcn_ds_read_tr16_b64_v4i16((LAS s16x4*)(vb + (ks * 64 + 16) * NA_LQ + nt * 32));
                    const bf16x8 vf = {v0[0], v0[1], v0[2], v0[3], v1[0], v1[1], v1[2], v1[3]};
                    o[nt] = __builtin_amdgcn_mfma_f32_16x16x32_bf16(vf, pf, o[nt], 0, 0, 0); } }
        } else {
        f32x4 s[8] = {};
        wave_mma_t<8, 2>(s, Ql + mtw * 16 * NA_LQ, NA_LQ, Kl + kh * 128 * NA_LQ, NA_LQ);
        float mx = -1e30f;
#pragma unroll
        for (int nt = 0; nt < 8; ++nt) mx = fmaxf(mx, fmaxf(fmaxf(s[nt][0], s[nt][1]), fmaxf(s[nt][2], s[nt][3])));
        mx = fmaxf(mx, __shfl_xor(mx, 16)); mx = fmaxf(mx, __shfl_xor(mx, 32));
        const float mn = fmaxf(m_run, mx), al = __expf(m_run - mn); m_run = mn;
        float rs = 0.f;
#pragma unroll
        for (int nt = 0; nt < 8; ++nt)
#pragma unroll
            for (int j = 0; j < 4; ++j) { const float e = __expf(s[nt][j] - mn); s[nt][j] = e; rs += e; }
        rs += __shfl_xor(rs, 16); rs += __shfl_xor(rs, 32);
        l_run = l_run * al + rs;
#pragma unroll
        for (int nt = 0; nt < 4; ++nt) o[nt] *= al;
        {
            const unsigned char* vb = Vl + (kh * 128 + 4 * fq + (fr >> 2)) * NA_LQ + (fr & 3) * 8;
#pragma unroll
            for (int ks = 0; ks < 4; ++ks) { const bf16x8 pf = na_pfrag(s[2 * ks], s[2 * ks + 1]);
#pragma unroll
                for (int nt = 0; nt < 4; ++nt) {
                    const s16x4 v0 = __builtin_amdgcn_ds_read_tr16_b64_v4i16((LAS s16x4*)(vb + ks * 32 * NA_LQ + nt * 32)), v1 = __builtin_amdgcn_ds_read_tr16_b64_v4i16((LAS s16x4*)(vb + (ks * 32 + 16) * NA_LQ + nt * 32));
                    const bf16x8 vf = {v0[0], v0[1], v0[2], v0[3], v1[0], v1[1], v1[2], v1[3]};
                    o[nt] = __builtin_amdgcn_mfma_f32_16x16x32_bf16(vf, pf, o[nt], 0, 0, 0); } } }
        }
    }
    if (kh == 1) { float* q = mrg + (mtw * 64 + lane) * 24; q[0] = m_run; q[1] = l_run;
#pragma unroll
        for (int nt = 0; nt < 4; ++nt) *(f32x4*)(q + 8 + nt * 4) = o[nt]; }
    __syncthreads();
    if (kh == 0) { const float* q = mrg + (mtw * 64 + lane) * 24; bf16_t* Z = (bf16_t*)(p->ws + WS_ZNA);
        const float m2 = q[0], l2 = q[1], mn = fmaxf(m_run, m2), a1 = __expf(m_run - mn), a2 = __expf(m2 - mn), inv = __builtin_amdgcn_rcpf(l_run * a1 + l2 * a2);
#pragma unroll
        for (int nt = 0; nt < 4; ++nt) { const f32x4 o2 = *(const f32x4*)(q + 8 + nt * 4); const f32x4 v = (o[nt] * a1 + o2 * a2) * inv;
            uint2 w; w.x = pk2(v[0], v[1]); w.y = pk2(v[2], v[3]); *(uint2*)(Z + (size_t)(qrow0 + mtw * 16 + fr) * 256 + h * 64 + nt * 16 + 4 * fq) = w; }
    }
}

constexpr int GL_L64 = 144;
constexpr int GL_LV = 272;
__device__ __forceinline__ bf16x8 tr_frag(const unsigned char* img, int ld, int k0, int c0) {
    const int lane = tidx() & 63, fr = lane & 15, fq = lane >> 4;
    const unsigned char* a = img + (k0 + 8 * fq + (fr >> 2)) * ld + (c0 + (fr & 3) * 4) * 2;
    const s16x4 v0 = __builtin_amdgcn_ds_read_tr16_b64_v4i16((LAS s16x4*)a), v1 = __builtin_amdgcn_ds_read_tr16_b64_v4i16((LAS s16x4*)(a + 4 * ld));
    return (bf16x8){v0[0], v0[1], v0[2], v0[3], v1[0], v1[1], v1[2], v1[3]};
}
__device__ __forceinline__ bf16x8 tr_frag_p(const unsigned char* img, int ld, int k0, int c0) {
    const int lane = tidx() & 63, fr = lane & 15, fq = lane >> 4;
    const unsigned char* a = img + (k0 + 4 * fq + (fr >> 2)) * ld + (c0 + (fr & 3) * 4) * 2;
    const s16x4 v0 = __builtin_amdgcn_ds_read_tr16_b64_v4i16((LAS s16x4*)a), v1 = __builtin_amdgcn_ds_read_tr16_b64_v4i16((LAS s16x4*)(a + 16 * ld));
    return (bf16x8){v0[0], v0[1], v0[2], v0[3], v1[0], v1[1], v1[2], v1[3]};
}
__device__ __forceinline__ void rope_regs(KP p, const bf16_t* src0, bool lat, int grow, float scale, float (&x)[8]) {
    const int tid = tidx(), t = tid >> 3, c = tid & 7, half = c >> 2, cc = c & 3;
    const bf16_t* src = src0 + (size_t)t * 64;
    const uint4 v = *(const uint4*)(src + c * 8); const unsigned w[4] = {v.x, v.y, v.z, v.w};
#pragma unroll
    for (int j = 0; j < 4; ++j) { x[2 * j] = bf2f(w[j] & 0xFFFFu); x[2 * j + 1] = bf2f(w[j] >> 16); }
    if (lat) {
        const uint4 pv = *(const uint4*)(src + (c ^ 2) * 8); const unsigned pw[4] = {pv.x, pv.y, pv.z, pv.w};
        const float* tb = (const float*)(p->ws + WS_ROPE) + (half ? 4096 + t * 16 : grow * 16) + (cc & 1) * 8;
        const float* ts = tb + (half ? 1024 : 2048);
        const float sg = (cc & 2) ? 1.f : -1.f;
#pragma unroll
        for (int j = 0; j < 8; ++j) { const float y = bf2f((j & 1) ? (pw[j >> 1] >> 16) : (pw[j >> 1] & 0xFFFFu)); x[j] = x[j] * tb[j] + sg * y * ts[j]; }
    }
#pragma unroll
    for (int j = 0; j < 8; ++j) x[j] *= scale;
}
__device__ __forceinline__ void gla_rope_tile(KP p, const bf16_t* src0, bool lat, int grow, float scale, float* dst) {
    const int tid = tidx(), t = tid >> 3, c = tid & 7, half = c >> 2, cc = c & 3;
    const bf16_t* src = src0 + (size_t)t * 64;
    const uint4 v = *(const uint4*)(src + c * 8); const unsigned* w = (const unsigned*)&v; float x[8];
#pragma unroll
    for (int j = 0; j < 4; ++j) { x[2 * j] = bf2f(w[j] & 0xFFFFu); x[2 * j + 1] = bf2f(w[j] >> 16); }
    if (lat) {
        const uint4 pv = *(const uint4*)(src + (c ^ 2) * 8); const unsigned* pw = (const unsigned*)&pv;
        const float* tb = (const float*)(p->ws + WS_ROPE) + (half ? 4096 + t * 16 : grow * 16) + (cc & 1) * 8;
        const float* ts = tb + (half ? 1024 : 2048);
        const float sg = (cc & 2) ? 1.f : -1.f;
#pragma unroll
        for (int j = 0; j < 8; ++j) { const float y = bf2f((j & 1) ? (pw[j >> 1] >> 16) : (pw[j >> 1] & 0xFFFFu)); x[j] = x[j] * tb[j] + sg * y * ts[j]; }
    }
#pragma unroll
    for (int j = 0; j < 8; ++j) dst[t * 65 + c * 8 + j] = x[j] * scale;
}
__device__ __forceinline__ void unit_gla_g1(KP p, int layer, int u) {
    const int bc = u >> 2, h = u & 3, b = bc / 132, c = bc % 132, row0 = b * RB + c * 64, tid = tidx(), lane = tid & 63, wave = tid >> 6, fr = lane & 15, fq = lane >> 4;
    const bool lat = c >= 4;
    float* bl = (float*)smem;
    float* kf = bl + 64 * 129;
    unsigned char* vR = (unsigned char*)(kf + 64 * 65);
    unsigned char* kE = vR + 64 * GL_LV;
    unsigned char* aL = kE + 64 * GL_L64;
    unsigned char* wB = aL + 64 * 80;
    const bf16_t* P = (const bf16_t*)(p->ws + WS_PROJ);
    __syncthreads();
    uint4 vv0, vv1, av = make_uint4(0u, 0u, 0u, 0u), wv0, wv1 = make_uint4(0u, 0u, 0u, 0u);
    { const int j = tid >> 4, cc = tid & 15; vv0 = *(const uint4*)(P + O_GV + (size_t)((b * 4 + h) * RB + c * 64 + j) * 128 + cc * 8); vv1 = *(const uint4*)(P + O_GV + (size_t)((b * 4 + h) * RB + c * 64 + j + 32) * 128 + cc * 8); }
    if (tid < 256) av = *(const uint4*)(P + O_GA + (size_t)(row0 + (tid >> 2)) * 32 + (tid & 3) * 8);
    wv0 = *(const uint4*)(p->ws + WS_GWB + ((size_t)layer * 4 + h) * 10240 + tid * 16);
    if (tid < 128) wv1 = *(const uint4*)(p->ws + WS_GWB + ((size_t)layer * 4 + h) * 10240 + (tid + NT) * 16);
    float gbias[4];
#pragma unroll
    for (int nt = 0; nt < 4; ++nt) { const int col = (wave >> 2) * 64 + nt * 16 + fr; gbias[nt] = p->in[23][((size_t)layer * 2 + (col >> 6)) * 256 + h * 64 + (col & 63)]; }
    { float kx[8]; rope_regs(p, P + O_GK + (size_t)((b * 4 + h) * RB + c * 64) * 64, lat, c - 4, 1.f, kx); const int t = tid >> 3, c8 = tid & 7;
#pragma unroll
      for (int j = 0; j < 8; ++j) kf[t * 65 + c8 * 8 + j] = kx[j]; }
    { const int j = tid >> 4, cc = tid & 15; *(uint4*)(vR + j * GL_LV + cc * 16) = vv0; *(uint4*)(vR + (j + 32) * GL_LV + cc * 16) = vv1; }
    if (tid < 256) *(uint4*)(aL + (tid >> 2) * 80 + (tid & 3) * 16) = av;
    *(uint4*)(wB + tid * 16) = wv0; if (tid < 128) *(uint4*)(wB + (tid + NT) * 16) = wv1;
    __syncthreads();
    { f32x4 z[4] = {};
      wave_mma<4, 1>(z, aL + (wave & 3) * 16 * 80, 80, wB + (wave >> 2) * 64 * 80, 80);
#pragma unroll
      for (int nt = 0; nt < 4; ++nt) { const int col = (wave >> 2) * 64 + nt * 16 + fr; const float bias = gbias[nt];
#pragma unroll
          for (int j = 0; j < 4; ++j) { const float zz = z[nt][j] + bias; bl[((wave & 3) * 16 + 4 * fq + j) * 129 + col] = (fminf(zz, 0.f) - __logf(1.f + __expf(-fabsf(zz)))) * (1.f / 16.f); } } }
    __syncthreads();
    for (int cc = 0; cc < 16; ++cc) {
        const int col = wave * 16 + cc; float v = bl[lane * 129 + col];
        v = col < 64 ? wave_prefix_sum(v) : wave_suffix_sum(v);
        bl[lane * 129 + col] = v;
    }
    __syncthreads();
    { unsigned short* BC = (unsigned short*)(p->ws + WS_BC);
      for (int i = tid; i < 64 * 16; i += NT) { const int t = i >> 4, c8 = i & 15, d = c8 >> 3; unsigned w[4];
#pragma unroll
          for (int j = 0; j < 4; ++j) { const float b0 = fminf(-bl[t * 129 + c8 * 8 + 2 * j] * 4096.f, 65535.f), b1 = fminf(-bl[t * 129 + c8 * 8 + 2 * j + 1] * 4096.f, 65535.f);
              w[j] = (unsigned)(b0 + 0.5f) | ((unsigned)(b1 + 0.5f) << 16); }
          *(uint4*)(BC + (((size_t)(row0 + t) * 4 + h) * 2 + d) * 64 + (c8 & 7) * 8) = make_uint4(w[0], w[1], w[2], w[3]); } }
    for (int d = 0; d < 2; ++d) {
        const int last = d == 0 ? 63 : 0;
        { const int j = tid >> 3, c8 = (tid & 7) * 8; float e8[8];
#pragma unroll
          for (int q = 0; q < 8; ++q) e8[q] = kf[j * 65 + c8 + q] * __expf(bl[last * 129 + d * 64 + c8 + q] - bl[j * 129 + d * 64 + c8 + q]);
          *(uint4*)(kE + j * GL_L64 + c8 * 2) = make_uint4(pk2(e8[0], e8[1]), pk2(e8[2], e8[3]), pk2(e8[4], e8[5]), pk2(e8[6], e8[7])); }
        const size_t unit = ((size_t)bc * 4 + h) * 2 + d;
        if (tid < 64) ((float*)(p->ws + WS_DECAY))[unit * 64 + tid] = __expf(bl[last * 129 + d * 64 + tid]);
        __syncthreads();
        f32x4 acc[4] = {};
        {
#pragma unroll
            for (int ks = 0; ks < 2; ++ks) { const bf16x8 ef = tr_frag(vR, GL_LV, ks * 32, wave * 16);
#pragma unroll
                for (int nt = 0; nt < 4; ++nt) { const bf16x8 kf8 = tr_frag(kE, GL_L64, ks * 32, nt * 16);
                    acc[nt] = __builtin_amdgcn_mfma_f32_16x16x32_bf16(kf8, ef, acc[nt], 0, 0, 0); } } }
        bf16_t* KV = (bf16_t*)kv_base(p, layer) + unit * 8192;
#pragma unroll
        for (int nt = 0; nt < 4; ++nt) { uint2 o; o.x = pk2(acc[nt][0], acc[nt][1]); o.y = pk2(acc[nt][2], acc[nt][3]); *(uint2*)(KV + (wave * 16 + fr) * 64 + nt * 16 + 4 * fq) = o; }
        __syncthreads();
    }
}
__device__ __forceinline__ int gla_order(int d, int i) { return d == 0 ? i : (i < 4 ? 3 - i : 135 - i); }
__device__ __forceinline__ void unit_gla_g2(KP p, int layer, int u, bool live = true) {
    const int bhd = u >> 3, sl = u & 7, b = bhd >> 3, h = (bhd >> 1) & 3, d = bhd & 1, tid = tidx();
    const int e2 = sl * 512 + tid;
    const int dk = (e2 * 2) & 63;
    unsigned* KV = (unsigned*)kv_base(p, layer); const float* DEC = (const float*)(p->ws + WS_DECAY);
    float s0 = 0.f, s1 = 0.f;
    for (int i0 = 0; i0 < 132; i0 += 22) {
        unsigned kv[22]; float2 dc[22]; size_t un[22];
#pragma unroll
        for (int j = 0; j < 22; ++j) { un[j] = (((size_t)b * 132 + gla_order(d, i0 + j)) * 4 + h) * 2 + d; kv[j] = KV[un[j] * 4096 + e2]; dc[j] = *(const float2*)(DEC + un[j] * 64 + dk); }
#pragma unroll
        for (int j = 0; j < 22; ++j) { if (live) KV[un[j] * 4096 + e2] = pk2(s0, s1); s0 = dc[j].x * s0 + bf2f(kv[j] & 0xFFFFu); s1 = dc[j].y * s1 + bf2f(kv[j] >> 16); }
    }
}
__device__ __forceinline__ void unit_gla_g3(KP p, int layer, int u) {
    const int bc = u >> 2, h = u & 3, b = bc / 132, c = bc % 132, row0 = b * RB + c * 64, tid = tidx(), lane = tid & 63, wave = tid >> 6, fr = lane & 15, fq = lane >> 4;
    const bool lat = c >= 4;
    unsigned char* qt = smem;
    unsigned char* kt = qt + 2 * 64 * GL_L64;
    unsigned char* vR = kt + 2 * 64 * GL_L64;
    unsigned char* sT = vR + 64 * GL_LV;
    float* ssq = (float*)(sT + 2 * 128 * GL_L64);
    const bf16_t* P = (const bf16_t*)(p->ws + WS_PROJ);
    __syncthreads();
    const int t = tid >> 3, c8 = tid & 7;
    const unsigned short* BCp = (const unsigned short*)(p->ws + WS_BC) + (((size_t)(row0 + t) * 4 + h) * 2) * 64 + c8 * 8;
    const uint4 bcv0 = *(const uint4*)(BCp), bcv1 = *(const uint4*)(BCp + 64);
    const bf16_t* KVp = (const bf16_t*)kv_base(p, layer) + (((size_t)bc * 4 + h) * 2) * 8192 + t * 64 + c8 * 8;
    const uint4 st00 = *(const uint4*)(KVp), st01 = *(const uint4*)(KVp + 4096), st10 = *(const uint4*)(KVp + 8192), st11 = *(const uint4*)(KVp + 8192 + 4096);
    uint4 vv0, vv1;
    { const int j = tid >> 4, cc = tid & 15; vv0 = *(const uint4*)(P + O_GV + (size_t)((b * 4 + h) * RB + c * 64 + j) * 128 + cc * 8); vv1 = *(const uint4*)(P + O_GV + (size_t)((b * 4 + h) * RB + c * 64 + j + 32) * 128 + cc * 8); }
    float kx[8], qx[8];
    rope_regs(p, P + O_GK + (size_t)((b * 4 + h) * RB + c * 64) * 64, lat, c - 4, 1.f, kx);
    rope_regs(p, P + O_GQ + (size_t)((b * 4 + h) * RB + c * 64) * 64, lat, c - 4, 0.125f, qx);
#pragma unroll
    for (int d = 0; d < 2; ++d) { const uint4 v = d ? bcv1 : bcv0; const unsigned bw[4] = {v.x, v.y, v.z, v.w}; float qs[8], ks[8];
#pragma unroll
        for (int j = 0; j < 8; ++j) { const float bb = -(float)((j & 1) ? (bw[j >> 1] >> 16) : (bw[j >> 1] & 0xFFFFu)) * (1.f / 4096.f); const float e = __expf(bb);
            qs[j] = qx[j] * e; ks[j] = kx[j] * __builtin_amdgcn_rcpf(e); }
        *(uint4*)(qt + (d * 64 + t) * GL_L64 + c8 * 16) = make_uint4(pk2(qs[0], qs[1]), pk2(qs[2], qs[3]), pk2(qs[4], qs[5]), pk2(qs[6], qs[7]));
        *(uint4*)(kt + (d * 64 + t) * GL_L64 + c8 * 16) = make_uint4(pk2(ks[0], ks[1]), pk2(ks[2], ks[3]), pk2(ks[4], ks[5]), pk2(ks[6], ks[7]));
    }
    { const int j = tid >> 4, cc = tid & 15; *(uint4*)(vR + j * GL_LV + cc * 16) = vv0; *(uint4*)(vR + (j + 32) * GL_LV + cc * 16) = vv1; }
    *(uint4*)(sT + t * GL_L64 + c8 * 16) = st00; *(uint4*)(sT + (64 + t) * GL_L64 + c8 * 16) = st01;
    *(uint4*)(sT + (128 + t) * GL_L64 + c8 * 16) = st10; *(uint4*)(sT + (192 + t) * GL_L64 + c8 * 16) = st11;
    const int mtw = wave & 3, nh = wave >> 2;
    f32x4 o[4] = {};
    __syncthreads();
#pragma unroll
    for (int d = 0; d < 2; ++d) {
        const unsigned char* qd = qt + d * 64 * GL_L64; const unsigned char* kd = kt + d * 64 * GL_L64;
        {
            f32x4 a[4] = {};
            wave_mma_t<4, 2>(a, qd + mtw * 16 * GL_L64, GL_L64, kd, GL_L64);
            const int ii = mtw * 16 + fr;
#pragma unroll
            for (int nt = 0; nt < 4; ++nt)
#pragma unroll
                for (int j = 0; j < 4; ++j) { const int jj = nt * 16 + 4 * fq + j; a[nt][j] = (d == 0 ? (jj <= ii) : (jj >= ii)) ? a[nt][j] : 0.f; }
#pragma unroll
            for (int ks = 0; ks < 2; ++ks) { const bf16x8 af = na_pfrag(a[2 * ks], a[2 * ks + 1]);
#pragma unroll
                for (int nt = 0; nt < 4; ++nt) o[nt] = __builtin_amdgcn_mfma_f32_16x16x32_bf16(tr_frag_p(vR, GL_LV, ks * 32, nh * 64 + nt * 16), af, o[nt], 0, 0, 0); } }
        wave_mma_t<4, 2>(o, qd + mtw * 16 * GL_L64, GL_L64, sT + (d * 128 + nh * 64) * GL_L64, GL_L64);
    }
    float ss = 0.f;
#pragma unroll
    for (int nt = 0; nt < 4; ++nt)
#pragma unroll
        for (int j = 0; j < 4; ++j) ss += o[nt][j] * o[nt][j];
    ss += __shfl_xor(ss, 16); ss += __shfl_xor(ss, 32);
    if (lane < 16) ssq[wave * 16 + lane] = ss;
    __syncthreads();
    const float rs = rsqrtf((ssq[mtw * 16 + fr] + ssq[(mtw + 4) * 16 + fr]) * (1.f / 128.f) + 1e-6f);
    bf16_t* Z = (bf16_t*)(p->ws + WS_GU);
    const int row = row0 + mtw * 16 + fr;
#pragma unroll
    for (int nt = 0; nt < 4; ++nt) { const int e = nh * 64 + nt * 16 + 4 * fq;
        const uint2 rr = *(const uint2*)(P + O_GR + (size_t)((b * 4 + h) * RB + c * 64 + mtw * 16 + fr) * 128 + e); const float4 ng = *(const float4*)(p->in[24] + layer * 128 + e);
        const float r0 = bf2f(rr.x & 0xFFFFu), r1 = bf2f(rr.x >> 16), r2 = bf2f(rr.y & 0xFFFFu), r3 = bf2f(rr.y >> 16);
        uint2 w; w.x = pk2(o[nt][0] * rs * ng.x * r0 * sigm(r0), o[nt][1] * rs * ng.y * r1 * sigm(r1)); w.y = pk2(o[nt][2] * rs * ng.z * r2 * sigm(r2), o[nt][3] * rs * ng.w * r3 * sigm(r3));
        *(uint2*)(Z + (size_t)row * 512 + h * 128 + e) = w; }
}

__device__ __forceinline__ void phase_merge_h(KP p, int layer, int bid, int nb) {
    const char* H = (const char*)(p->ws + WS_HKV); const bf16_t* WT = (const bf16_t*)(p->ws + WS_WT); bf16_t* M = (bf16_t*)(p->ws + WS_PROJ + PJ_MERGED);
    f32x4 accm[2][4][2]; uint2 brp[2][4][2];
    LAS unsigned char* gbl = (LAS unsigned char*)smem + 147456;
    auto tile_of = [&](int j, int& pm, int& pn) -> bool { int q;
        if (xcd_unit(bid, nb, j, 128, 8, q, pn)) { pm = (q >> 5) * 33 + 1 + (q & 31); return true; }
        if (layer != 0 || bid >= 32) return false;
        int q2, pn2; if (j > 0 && !xcd_unit(bid, nb, j - 1, 128, 8, q2, pn2)) return false;
        pm = (bid >> 3) * 33; pn = bid & 7; return true; };
    gemm256h3(smem,
        [&](int i, U256& u) -> bool { int pm, pn; if (!tile_of(i >> 3, pm, pn)) return false; const int sub = i & 7, br = sub >> 1;
            if (!(sub & 1)) { const char* Zb; size_t wo; int Kb;
                if (br == 0) { Zb = (const char*)(p->ws + WS_ZS5); wo = WT_WS5O; Kb = 256; } else if (br == 1) { Zb = (const char*)(p->ws + WS_GU); wo = WT_WGLAO; Kb = 512; }
                else if (br == 2) { Zb = (const char*)(p->ws + WS_ZNA); wo = WT_WNAO; Kb = 256; } else { Zb = (const char*)(p->ws + WS_ZCV); wo = WT_WCVO; Kb = 256; }
                u.A = Zb + (size_t)pm * 256 * Kb * 2; u.B = (const char*)(WT + wo) + (size_t)pn * 128 * Kb * 2; u.K = Kb; u.f8 = 0; }
            else { u.A = (const char*)p->out + OUT_H8 + (size_t)pm * 256 * D; u.B = (const char*)(p->ws + WS_WG8) + (size_t)(br * 1024 + pn * 128) * D; u.K = D / 2; u.f8 = 1; }
            return true; },
        [&](int i, f32x4 (&acc)[2][4][2], int wr, int wc, int fr, int fq) {
            int pm, pn; tile_of(i >> 3, pm, pn); const int sub = i & 7, br = sub >> 1;
            if (!(sub & 1)) {
#pragma unroll
                for (int ai = 0; ai < 2; ++ai)
#pragma unroll
                    for (int m = 0; m < 4; ++m)
#pragma unroll
                        for (int n = 0; n < 2; ++n) { brp[ai][m][n].x = pk2(acc[ai][m][n][0], acc[ai][m][n][1]); brp[ai][m][n].y = pk2(acc[ai][m][n][2], acc[ai][m][n][3]); }
                __builtin_amdgcn_global_load_lds((const unsigned*)(p->in[9] + (size_t)layer * 4096 + br * 1024 + pn * 128 + wc * 32 + ((fq & 1) * 16 + fr)), (LAS unsigned*)(gbl + (wr * 4 + wc) * 256), 4, 0, 0);
            } else {
                constexpr float NL2E = -1.4426950408889634f, NL2E_A = NL2E / 32.f;
                const LAS f32x4* bl = (const LAS f32x4*)(gbl + (wr * 4 + wc) * 256);
                const f32x4 gb0 = bl[fq], gb1 = bl[4 + fq];
                const float4 b0 = {gb0[0] * NL2E, gb0[1] * NL2E, gb0[2] * NL2E, gb0[3] * NL2E}, b1 = {gb1[0] * NL2E, gb1[1] * NL2E, gb1[2] * NL2E, gb1[3] * NL2E};
#pragma unroll
                for (int ai = 0; ai < 2; ++ai)
#pragma unroll
                    for (int m = 0; m < 4; ++m)
#pragma unroll
                        for (int n = 0; n < 2; ++n) { const f32x4 v = acc[ai][m][n]; const float4 bb = n ? b1 : b0; const uint2 bp = brp[ai][m][n];
                            const float s0 = __builtin_amdgcn_rcpf(1.f + __builtin_amdgcn_exp2f(__builtin_fmaf(v[0], NL2E_A, bb.x))), s1 = __builtin_amdgcn_rcpf(1.f + __builtin_amdgcn_exp2f(__builtin_fmaf(v[1], NL2E_A, bb.y))),
                                        s2 = __builtin_amdgcn_rcpf(1.f + __builtin_amdgcn_exp2f(__builtin_fmaf(v[2], NL2E_A, bb.z))), s3 = __builtin_amdgcn_rcpf(1.f + __builtin_amdgcn_exp2f(__builtin_fmaf(v[3], NL2E_A, bb.w)));
                            const float t0 = bf2f(bp.x & 0xFFFFu), t1 = bf2f(bp.x >> 16), t2 = bf2f(bp.y & 0xFFFFu), t3 = bf2f(bp.y >> 16);
                            if (br == 0) accm[ai][m][n] = (f32x4){s0 * t0, s1 * t1, s2 * t2, s3 * t3};
                            else { accm[ai][m][n][0] = __builtin_fmaf(s0, t0, accm[ai][m][n][0]); accm[ai][m][n][1] = __builtin_fmaf(s1, t1, accm[ai][m][n][1]);
                                   accm[ai][m][n][2] = __builtin_fmaf(s2, t2, accm[ai][m][n][2]); accm[ai][m][n][3] = __builtin_fmaf(s3, t3, accm[ai][m][n][3]); } }
                if (br == 3) {
                    bf16_t* mrow = M + (size_t)(pm * 256 + wr * 64 + fr) * D + pn * 128 + wc * 32 + fq * 4;
#pragma unroll
                    for (int ai = 0; ai < 2; ++ai)
#pragma unroll
                        for (int m = 0; m < 4; ++m)
#pragma unroll
                            for (int n = 0; n < 2; ++n) { uint2 o; o.x = pk2(accm[ai][m][n][0], accm[ai][m][n][1]); o.y = pk2(accm[ai][m][n][2], accm[ai][m][n][3]);
                                *(uint2*)(mrow + (size_t)(ai * 128 + m * 16) * D + n * 16) = o; }
                }
            } });
}
__device__ __forceinline__ void phase_mix_ctx(KP p, int layer, int bid, int nb) {
    typedef GT<256, 128, 4, 2> G;
    const int tid = tidx(), lane = tid & 63, wave = tid >> 6, wm = wave >> 1, wn = wave & 1, fr = lane & 15, fq = lane >> 4;
    const bf16_t* M = (const bf16_t*)(p->ws + WS_PROJ + PJ_MERGED); const bf16_t* W = (const bf16_t*)(p->ws + WS_WT) + WT_WMIX;
    const int nunit = 4 * 8;
    gemm_stream<256, 128, 4, 2>(
        [&](int s, cbfp (&ap)[G::AI], long& kstep, cbfp (&bp)[G::BI], int& nk) -> bool {
            const int u = bid + s * nb; if (u >= nunit) return false; const int q = u >> 3, pn = u & 7, pm = q * 33;
#pragma unroll
            for (int i = 0; i < G::AI; ++i) ap[i] = M + (size_t)(pm * 256 + st_row(i)) * D + st_chunk(i) * 8;
#pragma unroll
            for (int i = 0; i < G::BI; ++i) bp[i] = W + (size_t)(pn * 128 + st_row(i)) * D + st_chunk(i) * 8;
            kstep = 64; nk = 16; return true; },
        [&](int s, f32x4 (&acc)[G::MT][G::NTL]) {
            const int u = bid + s * nb, q = u >> 3, pn = u & 7, pm = q * 33;
            const float* g1 = mod_vec(p, layer, pm * 256) + 2048;
#pragma unroll
            for (int mt = 0; mt < G::MT; ++mt)
#pragma unroll
                for (int nt = 0; nt < G::NTL; ++nt) { const int row = pm * 256 + wm * 64 + mt * 16 + fr, col = pn * 128 + wn * 64 + nt * 16 + fq * 4;
                    const float4 xo = *(const float4*)(xsrc_row(p, layer, row) + col), gg = *(const float4*)(g1 + col);
                    *(float4*)(xdst_row(p, row) + col) = make_float4(xo.x + gg.x * acc[mt][nt][0], xo.y + gg.y * acc[mt][nt][1], xo.z + gg.z * acc[mt][nt][2], xo.w + gg.w * acc[mt][nt][3]); }
            ZERO_ACC(acc, G::MT, G::NTL); },
        smem);
}

__device__ __forceinline__ void phase_mix256(KP p, int layer, int bid, int nb, bool live = true) {
    const char* M = (const char*)(p->ws + WS_PROJ + PJ_MERGED); const char* W = (const char*)((const bf16_t*)(p->ws + WS_WT) + WT_WMIX);
    gemm256(smem,
        [&](int i, U256& u) -> bool { int q, pn; if (!xcd_unit(bid, nb, i, 128, 4, q, pn)) return false; const int pm = (q >> 5) * 33 + 1 + (q & 31);
            u.A = M + (size_t)pm * 256 * D * 2; u.B = W + (size_t)pn * 256 * D * 2; u.K = D; return true; },
        [&](int i, f32x4 (&acc)[2][2][4][2], int wr, int wc, int fr, int fq) {
            int q, pn; xcd_unit(bid, nb, i, 128, 4, q, pn); const int pm = (q >> 5) * 33 + 1 + (q & 31);
            const float* g1 = mod_vec(p, layer, pm * 256) + 2048 + pn * 256 + wc * 32 + fq * 4;
            const size_t eoff = (size_t)(wr * 64 + fr) * D + pn * 256 + wc * 32 + fq * 4;
            const float* xs = p->in[0] + (size_t)((pm / 33) * SEQ + (pm % 33 - 1) * 256) * D + eoff; bf16_t* xd = xb_row(p, pm * 256) + eoff;
#pragma unroll
            for (int bj = 0; bj < 2; ++bj)
#pragma unroll
                for (int n = 0; n < 2; ++n) { const float4 gg = *(const float4*)(g1 + bj * 128 + n * 16);
                    float4 xo8[2][4];
#pragma unroll
                    for (int ai = 0; ai < 2; ++ai)
#pragma unroll
                        for (int m = 0; m < 4; ++m) { const size_t o = (size_t)(ai * 128 + m * 16) * D + bj * 128 + n * 16; xo8[ai][m] = layer == 0 ? *(const float4*)(xs + o) : bf4(*(const uint2*)(xd + o)); }
#pragma unroll
                    for (int ai = 0; ai < 2; ++ai)
#pragma unroll
                        for (int m = 0; m < 4; ++m) { const size_t o = (size_t)(ai * 128 + m * 16) * D + bj * 128 + n * 16; const f32x4 v = acc[ai][bj][m][n]; const float4 xo = xo8[ai][m];
                            uint2 w; w.x = pk2(xo.x + gg.x * v[0], xo.y + gg.y * v[1]); w.y = pk2(xo.z + gg.z * v[2], xo.w + gg.w * v[3]);
                            if (live) *(uint2*)(xd + o) = w; } } });
}

__device__ __forceinline__ void moe_tiles(KP p, int layer, int* tt) {
    int* sc = tt + 768;
    __syncthreads();
    if (tidx() < NCLS) sc[tidx()] = (int)__hip_atomic_load((const unsigned*)(p->ws + WS_CTL + CTL_CNT) + layer * 128 * 64 + tidx() * 64, __ATOMIC_RELAXED, __HIP_MEMORY_SCOPE_AGENT);
    __syncthreads();
    if (tidx() == 0) { int n = 0;
        for (int c = 0; c < NCLS; ++c) { const int k = sc[c];
            for (int r0 = 0; r0 < k && n < MAXTILES; r0 += 128) { tt[1 + 2 * n] = c; tt[2 + 2 * n] = r0; ++n; } }
        tt[0] = n; }
    __syncthreads();
}
__device__ __forceinline__ int moe_unit(int bid, int nb, int s) { const int nrank = nb >> 3; return (s * 8 + (bid & 7)) * nrank + (bid >> 3); }
__device__ __forceinline__ void cls_experts(int cls, int& ea, int& eb) {
    const int gi = cls / 28; int q = cls % 28, a = 0;
    while (q >= 7 - a) { q -= 7 - a; ++a; }
    ea = gi * 8 + a; eb = gi * 8 + a + 1 + q;
}
__device__ __forceinline__ void phase_moe_up(KP p, int layer, const int* tt, int bid, int nb) {
    const int nunit = tt[0] * 4;
    const char* H8 = (const char*)p->out + OUT_H8; bf16_t* ACT = (bf16_t*)(p->ws + WS_PROJ + PJ_ACT); const float2* tokw = (const float2*)(p->ws + WS_PROJ + PJ_TOKW);
    const unsigned* cnts = (const unsigned*)(p->ws + WS_CTL + CTL_CNT) + layer * 128 * 64;
    gemm256h3g(smem,
        [&](int i, U256& u) -> bool { const int un = moe_unit(bid, nb, i); if (un >= nunit) return false;
            const int tile = un >> 2, pn = un & 3, cls = tt[1 + 2 * tile], r0 = tt[2 + 2 * tile], slot = pn >> 1, hf = pn & 1, cnt = (int)cnts[cls * 64];
            int ea, eb; cls_experts(cls, ea, eb); const int ex = slot ? eb : ea;
            u.A = (const char*)((const bf16_t*)(p->ws + WS_WT) + WT_W13) + ((size_t)ex * 512 + (size_t)hf * 256) * 1024; u.B = H8; u.K = D / 2; u.f8 = 1;
            u.gidx = (const int*)(p->ws + WS_PROJ + PJ_PERM) + (size_t)cls * MOE_CAP + r0; u.gmax = cnt - r0; u.pB = D / 2; u.cont = 0; return true; },
        [&](int i, f32x4 (&acc)[2][4][2], int wr, int wc, int fr, int fq, const LAS int* rows) {
            const int un = moe_unit(bid, nb, i), tile = un >> 2, pn = un & 3, cls = tt[1 + 2 * tile], r0 = tt[2 + 2 * tile], slot = pn >> 1, hf = pn & 1, cnt = (int)cnts[cls * 64];
#pragma unroll
            for (int n = 0; n < 2; ++n) { const int tk = wc * 32 + n * 16 + fr; const bool ok = r0 + tk < cnt; float w = 0.f;
                if (ok) { const float2 tw = tokw[rows[tk]]; w = (slot ? tw.y : tw.x) * (1.f / 32.f); }
                unsigned char* arow = (unsigned char*)ACT + ((size_t)tile * 128 + tk) * 512 + slot * 256 + hf * 128 + wr * 64 + fq * 4;
                const float w16 = w * 8.f;
#pragma unroll
                for (int m = 0; m < 4; ++m) { const f32x4 a = acc[0][m][n], bq = acc[1][m][n]; unsigned o = 0u;
                    if (ok) { const float a0 = a[0] * (1.f / 32.f), a1 = a[1] * (1.f / 32.f), a2 = a[2] * (1.f / 32.f), a3 = a[3] * (1.f / 32.f);
                        o = f8x4(a0 * sigm(a0) * bq[0] * w16, a1 * sigm(a1) * bq[1] * w16, a2 * sigm(a2) * bq[2] * w16, a3 * sigm(a3) * bq[3] * w16); }
                    *(unsigned*)(arow + m * 16) = o; } } });
}
__device__ __forceinline__ void phase_moe_down(KP p, int layer, const int* tt, int bid, int nb, bool live = true) {
    const int nunit = tt[0] * 4;
    const unsigned char* ACT8 = (const unsigned char*)(p->ws + WS_PROJ + PJ_ACT); const unsigned char* W28 = (const unsigned char*)((const bf16_t*)(p->ws + WS_WT) + WT_W2);
    const unsigned* cnts = (const unsigned*)(p->ws + WS_CTL + CTL_CNT) + layer * 128 * 64;
    gemm256h3g(smem,
        [&](int i, U256& u) -> bool { const int un = moe_unit(bid, nb, i >> 1); if (un >= nunit) return false;
            const int slot = i & 1, tile = un >> 2, pn = un & 3, cls = tt[1 + 2 * tile];
            int ea, eb; cls_experts(cls, ea, eb); const int ex = slot ? eb : ea;
            u.A = (const char*)W28 + ((size_t)ex * 1024 + pn * 256) * 256; u.B = (const char*)ACT8 + (size_t)tile * 128 * 512 + slot * 256; u.K = 128; u.f8 = 1;
            u.gidx = nullptr; u.gmax = 128; u.pB = 256; u.cont = slot == 0; return true; },
        [&](int i, f32x4 (&acc)[2][4][2], int wr, int wc, int fr, int fq, const LAS int*) {
            const int un = moe_unit(bid, nb, i >> 1), tile = un >> 2, pn = un & 3, cls = tt[1 + 2 * tile], r0 = tt[2 + 2 * tile], cnt = (int)cnts[cls * 64];
            const int* perm = (const int*)(p->ws + WS_PROJ + PJ_PERM) + (size_t)cls * MOE_CAP;
            const int c0 = pn * 256 + wr * 64 + fq * 4;
            int rows2[2];
#pragma unroll
            for (int n = 0; n < 2; ++n) { const int tk = wc * 32 + n * 16 + fr; rows2[n] = r0 + tk < cnt ? perm[r0 + tk] : -1; }
            uint2 xr8[2][2][4]; float4 gg8[2][2][4];
#pragma unroll
            for (int n = 0; n < 2; ++n) { const int row = rows2[n];
                if (row >= 0 && row % RB >= CTX) { const float* g2 = mod_vec(p, layer, row) + 5120 + c0; const bf16_t* xr = xb_row(p, row) + c0;
#pragma unroll
                    for (int ai = 0; ai < 2; ++ai)
#pragma unroll
                        for (int m = 0; m < 4; ++m) { const int o = ai * 128 + m * 16; gg8[n][ai][m] = *(const float4*)(g2 + o); xr8[n][ai][m] = *(const uint2*)(xr + o); } } }
#pragma unroll
            for (int n = 0; n < 2; ++n) { const int row = rows2[n];
                if (row >= 0) {
                    if (row % RB < CTX) { float* xr = xdst_row(p, row) + c0; const float* g2 = mod_vec(p, layer, row) + 5120 + c0;
#pragma unroll
                        for (int ai = 0; ai < 2; ++ai)
#pragma unroll
                            for (int m = 0; m < 4; ++m) { const int o = ai * 128 + m * 16; const float4 gg = *(const float4*)(g2 + o); float4 xo = *(float4*)(xr + o); const f32x4 v = acc[ai][m][n] * (1.f / 128.f);
                                xo.x += gg.x * v[0]; xo.y += gg.y * v[1]; xo.z += gg.z * v[2]; xo.w += gg.w * v[3]; if (live) *(float4*)(xr + o) = xo; }
                    } else { bf16_t* xw = x2_row(p, layer, row) + c0;
#pragma unroll
                        for (int ai = 0; ai < 2; ++ai)
#pragma unroll
                            for (int m = 0; m < 4; ++m) { const int o = ai * 128 + m * 16; const float4 gg = gg8[n][ai][m]; const float4 xo = bf4(xr8[n][ai][m]); const f32x4 v = acc[ai][m][n] * (1.f / 128.f);
                                uint2 w; w.x = pk2(xo.x + gg.x * v[0], xo.y + gg.y * v[1]); w.y = pk2(xo.z + gg.z * v[2], xo.w + gg.w * v[3]); if (live) *(uint2*)(xw + o) = w; } } } } });
}

__device__ __forceinline__ void phase_final_norm(KP p) {
    const int wave = tidx() >> 6, lane = tidx() & 63;
    const float* g = p->in[40];
    for (int row = blockIdx.x * 8 + wave; row < NB * SEQ; row += gridDim.x * 8) {
        float4* xr = (float4*)(p->out + (size_t)row * D); const uint2* xi = (const uint2*)((const bf16_t*)(p->ws + WS_HKV) + (size_t)row * D);
        float4 v[4]; float ss = 0.f;
#pragma unroll
        for (int i = 0; i < 4; ++i) { v[i] = bf4(xi[lane + 64 * i]); ss += v[i].x * v[i].x + v[i].y * v[i].y + v[i].z * v[i].z + v[i].w * v[i].w; }
        ss = wave_sum(ss);
        const float rs = rsqrtf(ss * (1.f / D) + 1e-6f);
#pragma unroll
        for (int i = 0; i < 4; ++i) { const float4 gg = ((const float4*)g)[lane + 64 * i];
            xr[lane + 64 * i] = make_float4(v[i].x * rs * gg.x, v[i].y * rs * gg.y, v[i].z * rs * gg.z, v[i].w * rs * gg.w); }
    }
}

#ifndef EN_S5
#define EN_S5 1
#endif
#ifndef EN_GLA
#define EN_GLA 1
#endif
#ifndef EN_NA
#define EN_NA 1
#endif
#ifndef EN_CV
#define EN_CV 1
#endif
#ifndef EN_MIX
#define EN_MIX 1
#endif
#ifndef EN_MOE
#define EN_MOE 1
#endif

__device__ __forceinline__ KP fresh_params(KP q) { asm volatile("" : "+s"(q)); return q; }
__global__ void __launch_bounds__(NT, 2) fwd(Params pv) {
    KP pp = (KP)__builtin_amdgcn_kernarg_segment_ptr();
    asm volatile("" : "+s"(pp));
    KP p = pp;
#define PF (fresh_params(pp))
    LAS unsigned* xbw = (LAS unsigned*)(smem + LDS_BYTES - 16);
    if (tidx() == 0) { xbw[0] = 0u; xbw[1] = 0u; xbw[2] = 0u; xbw[3] = 0u; }
    __syncthreads();
    XcdBarrier bar = xcd_barrier_post(pp, (volatile LAS unsigned*)xbw);
    const int bid = blockIdx.x, nb = gridDim.x;

    for (int u = (bid + 32) & 255; u < 192 + 9 + 32; u += 256) {
        if (u < 32) unit_s5w(PF, u);
        else if (u < 224) unit_mod(PF, u - 32);
        else unit_tables(PF, u - 224);
    }
    __syncthreads();
    xcd_barrier(bar);

#pragma unroll 1
    for (int layer = 0; layer < 2; ++layer) {
        phase_norm(PF, layer, 0, bid, nb);
        { __syncthreads(); for (int t = bid * 8 + (tidx() >> 6); t < CV_TILES; t += nb * 8) wave_convert(PF, layer, t); }
        xcd_barrier(bar);
#if EN_MIX
        phase_inproj(PF, bid, nb);
        xcd_barrier(bar);
        {
            const int n_na = EN_NA ? (layer == 0 ? 2112 : 2048) : 0, n_g1 = EN_GLA ? 2112 : 0, n_cv = EN_CV ? 528 : 0;
            const int ntot = n_na + n_g1 + n_cv, m = bid < ntot ? (ntot - bid + nb - 1) / nb : 0, sh = (bid & 1) ? (n_na - bid + nb - 1) / nb : 0;
            for (int k = 0; k < m; ++k) { const int kk = k + sh < m ? k + sh : k + sh - m; const int u = bid + kk * nb;
                if (u < n_na) unit_na(PF, layer, (nb == 256 && (u | 255) < n_na) ? ((u & ~255) | ((u & 7) << 5) | ((u & 255) >> 3)) : u);
                else if (u < n_na + n_g1) unit_gla_g1(PF, layer, u - n_na);
                else unit_conv(PF, layer, u - n_na - n_g1);
            }
            if (EN_S5) phase_s5_gemm1(PF, layer, nb - 1 - bid, nb);
        }
        xcd_barrier(bar);
        {
            const int n_s = EN_S5 ? 128 : 0, n_g = EN_GLA ? 256 : 0;
            for (int u = bid; u < n_s + n_g; u += nb) { if (u < n_s) unit_s5_scan(PF, layer, u); else unit_gla_g2(PF, layer, u - n_s); }
        }
        xcd_barrier(bar);
        {
            const int n_g3 = EN_GLA ? 2112 : 0;
            for (int u = bid; u < n_g3; u += nb) unit_gla_g3(PF, layer, u);
            if (EN_S5) phase_s5_gemm2(PF, layer, nb - 1 - bid, nb);
        }
        xcd_barrier(bar);
        if (EN_S5) phase_s5_glu(PF, layer, bid, nb);
        xcd_barrier(bar);
        phase_merge_h(PF, layer, bid, nb);
        xcd_barrier(bar);
        if (layer == 0) phase_mix_ctx(PF, layer, nb - 1 - bid, nb);
        phase_mix256(PF, layer, bid, nb);
        xcd_barrier(bar);
#else
        if (layer == 0) {
            for (int r = bid * 8 + (tidx() >> 6); r < R; r += nb * 8) { const float4* s = (const float4*)xsrc_row(p, 0, r); float4* d = (float4*)xdst_row(p, r);
                for (int i = tidx() & 63; i < 256; i += 64) d[i] = s[i]; }
            xcd_barrier(bar);
        }
#endif
#if EN_MOE
        phase_norm(PF, layer, 1, bid, nb);
        xcd_barrier(bar);
        int* tt = (int*)(smem + LDS_BYTES - 4096);
        moe_tiles(PF, layer, tt);
        phase_moe_up(PF, layer, tt, bid, nb);
        xcd_barrier(bar);
        phase_moe_down(PF, layer, tt, bid, nb);
        xcd_barrier(bar);
#endif
    }
    phase_final_norm(PF);
}

extern "C" void kernel_launch(void* const* d_in, const int* in_sizes, int n_in, void* d_out, int out_size, void* d_ws, size_t ws_size, hipStream_t stream) {
    static int grid = 0;
    if (grid == 0) {
        int dev = 0, cus = 0, per_cu = 0;
        if (n_in != 41 || out_size != NB * SEQ * D || ws_size < WS_END) { fprintf(stderr, "kernel_launch: unexpected shapes (n_in %d out %d ws %zu need %zu)\n", n_in, out_size, ws_size, (size_t)WS_END); grid = -1; return; }
        if (hipGetDevice(&dev) != hipSuccess || hipDeviceGetAttribute(&cus, hipDeviceAttributeMultiprocessorCount, dev) != hipSuccess) { grid = -1; return; }
        if (hipFuncSetAttribute((const void*)fwd, hipFuncAttributeMaxDynamicSharedMemorySize, LDS_BYTES) != hipSuccess) { grid = -1; return; }
        if (hipOccupancyMaxActiveBlocksPerMultiprocessor(&per_cu, (const void*)fwd, NT, LDS_BYTES) != hipSuccess || per_cu < 1) per_cu = 1;
        (void)hipGetLastError();
        grid = cus & ~7;
    }
    if (grid < 0) return;
    (void)hipMemsetAsync(d_ws, 0, CTL_BYTES, stream);
    Params p{};
    for (int i = 0; i < 41; ++i) p.in[i] = (const float*)d_in[i];
    p.out = (float*)d_out; p.ws = (unsigned char*)d_ws;
    hipLaunchKernelGGL(fwd, dim3(grid), dim3(NT), LDS_BYTES, stream, p);
}
```
